# Optimizing an MI355X kernel written in HIP

```python
import jax, jax.numpy as jnp
from jax import lax
import numpy as np

D_MODEL = 1024
BATCH = 8
SEQ = 4096
DEPTH = 2
DEC_BATCH = 16
DEC_SEQ = 32
PAST_LEN = 2048

CHUNK = 64
N_HEADS = 8
N_KV_HEADS = 2
HEAD_DIM = 64
ATTN_DIM = N_HEADS * HEAD_DIM
KV_DIM = N_KV_HEADS * HEAD_DIM
IDX_HEADS = 4
IDX_DIM = 64
TOPK_MAX = 256
Q_BLOCK = 128
GMLP_CHUNK = 128
GMLP_GROUPS = 4
GMLP_DIM = 512
GMLP_GROUP_DIM = GMLP_DIM // GMLP_GROUPS
D_FF = 4 * D_MODEL
ROPE_THETA = 500000.0
ROPE_DIM = HEAD_DIM // 4
IDX_ROPE_DIM = IDX_DIM // 4
ALPHA = (2 * DEPTH) ** 0.25
BETA = (8 * DEPTH) ** -0.25
LN_EPS = 1e-5
IN_DIM = ATTN_DIM + 2 * KV_DIM + IDX_HEADS * IDX_DIM + IDX_DIM + IDX_HEADS + 2 * GMLP_DIM + 2 * D_MODEL

kernel_name = 'dsa_gmlp_gated_hybrid_stream_step'


def _layer_norm(x, g, b):
    xf = x.astype(jnp.float32)
    mu = jnp.mean(xf, axis=-1, keepdims=True)
    var = jnp.mean(jnp.square(xf - mu), axis=-1, keepdims=True)
    y = (xf - mu) * lax.rsqrt(var + LN_EPS)
    return (y * g.astype(jnp.float32) + b.astype(jnp.float32)).astype(x.dtype)


def _rope(x, pos, rot_dim):
    half = rot_dim // 2
    freqs = ROPE_THETA ** (-jnp.arange(half, dtype=jnp.float32) * 2.0 / rot_dim)
    ang = pos.astype(jnp.float32)[:, None] * freqs[None, :]
    ang = ang.reshape(ang.shape[:1] + (1,) * (x.ndim - 3) + (half,))
    cos, sin = jnp.cos(ang), jnp.sin(ang)
    xf = x.astype(jnp.float32)
    x1, x2, rest = xf[..., :half], xf[..., half:rot_dim], xf[..., rot_dim:]
    out = jnp.concatenate([x1 * cos - x2 * sin, x1 * sin + x2 * cos, rest], axis=-1)
    return out.astype(x.dtype)


def _mixer_inputs(x, pos, w_in, idx_k_g, idx_k_b):
    B, T, _ = x.shape
    sizes = (ATTN_DIM, KV_DIM, KV_DIM, IDX_HEADS * IDX_DIM, IDX_DIM, IDX_HEADS,
             GMLP_DIM, GMLP_DIM, D_MODEL, D_MODEL)
    points = [int(p) for p in np.cumsum(sizes)[:-1]]
    q, k, v, qi, ki, wi, u, vg, ga, gb = jnp.split(x @ w_in, points, axis=-1)
    q = _rope(q.reshape(B, T, N_HEADS, HEAD_DIM), pos, ROPE_DIM)
    k = _rope(k.reshape(B, T, N_KV_HEADS, HEAD_DIM), pos, ROPE_DIM)
    v = v.reshape(B, T, N_KV_HEADS, HEAD_DIM)
    qi = _rope(qi.reshape(B, T, IDX_HEADS, IDX_DIM), pos, IDX_ROPE_DIM)
    ki = _rope(_layer_norm(ki, idx_k_g, idx_k_b), pos, IDX_ROPE_DIM)
    return q, k, v, qi, ki, wi, u, vg, ga, gb


def _sparse_attend(q, qi, wi, qpos, k, v, ki, topk):
    B, Q = q.shape[:2]
    S = k.shape[1]
    limit = (qpos // CHUNK + 1) * CHUNK
    dots = jnp.einsum('bqhd,bsd->bqhs', qi.astype(jnp.float32), ki.astype(jnp.float32)) * IDX_DIM ** -0.5
    score = jnp.einsum('bqh,bqhs->bqs', wi.astype(jnp.float32) * IDX_HEADS ** -0.5, jax.nn.relu(dots))
    admissible = jnp.arange(S)[None, :] < limit[:, None]
    score = jnp.where(admissible[None], score, -jnp.inf)
    _, sel = lax.top_k(score, topk)
    valid = sel < limit[None, :, None]
    k_sel = jax.vmap(lambda kk, ii: kk[ii])(k, sel)
    v_sel = jax.vmap(lambda vv, ii: vv[ii])(v, sel)
    qg = q.reshape(B, Q, N_KV_HEADS, N_HEADS // N_KV_HEADS, HEAD_DIM)
    logits = jnp.einsum('bqngd,bqknd->bqngk', qg.astype(jnp.float32), k_sel.astype(jnp.float32)) * HEAD_DIM ** -0.5
    logits = jnp.where(valid[:, :, None, None, :], logits, -jnp.inf)
    p = jax.nn.softmax(logits, axis=-1)
    o = jnp.einsum('bqngk,bqknd->bqngd', p.astype(v_sel.dtype), v_sel)
    return o.reshape(B, Q, ATTN_DIM)


def _prompt_attention(q, k, v, qi, ki, wi, topk):
    B, T = q.shape[:2]
    nb = T // Q_BLOCK

    def blockify(a):
        return jnp.moveaxis(a.reshape((B, nb, Q_BLOCK) + a.shape[2:]), 1, 0)

    def one_block(args):
        qb, qib, wib, blk = args
        qpos = blk * Q_BLOCK + jnp.arange(Q_BLOCK)
        return _sparse_attend(qb, qib, wib, qpos, k, v, ki, topk)

    out = lax.map(one_block, (blockify(q), blockify(qi), blockify(wi), jnp.arange(nb)))
    return jnp.moveaxis(out, 0, 1).reshape(B, T, ATTN_DIM)


def _causal_ws(w_s):
    mask = jnp.tril(jnp.ones((GMLP_CHUNK, GMLP_CHUNK), dtype=bool))
    return jnp.where(mask[None], w_s, jnp.zeros_like(w_s))


def _sgu_prompt(u, vn, w_s, b_s):
    B, T, _ = u.shape
    vr = vn.reshape(B, T // GMLP_CHUNK, GMLP_CHUNK, GMLP_GROUPS, GMLP_GROUP_DIM)
    mix = jnp.einsum('gts,bcsgd->bctgd', _causal_ws(w_s), vr) + b_s.T[:, :, None]
    return u * mix.reshape(B, T, GMLP_DIM)


def _sgu_sample(u, vn, w_s, b_s):
    B, T, _ = u.shape
    vr = vn.reshape(B, T, GMLP_GROUPS, GMLP_GROUP_DIM)
    mix = jnp.einsum('gts,bsgd->btgd', _causal_ws(w_s)[:, :T, :T], vr) + b_s[:, :T].T[:, :, None]
    return u * mix.reshape(B, T, GMLP_DIM)


def _post_block(x, o_a, o_b, ga, gb, w_pa, w_pb, w_out, ln1_g, ln1_b, w_ff1, w_ff2, ln2_g, ln2_b):
    merged = jax.nn.sigmoid(ga) * (o_a @ w_pa) + jax.nn.sigmoid(gb) * (o_b @ w_pb)
    x = _layer_norm(ALPHA * x + merged @ w_out, ln1_g, ln1_b)
    ff = jnp.square(jax.nn.relu(x @ w_ff1)) @ w_ff2
    return _layer_norm(ALPHA * x + ff, ln2_g, ln2_b)


def setup_inputs(seed: int = 0) -> dict:
    key = jax.random.key(seed)
    ks = jax.random.split(key, 24)

    def nrm(k, shape, scale):
        return jax.random.normal(k, shape, jnp.float32) * scale

    return {
        'x_prompt': nrm(ks[0], (BATCH, SEQ, D_MODEL), 1.0),
        'x_sample': nrm(ks[1], (DEC_BATCH, DEC_SEQ, D_MODEL), 1.0),
        'cache_k': nrm(ks[2], (DEPTH, DEC_BATCH, PAST_LEN, N_KV_HEADS, HEAD_DIM), 1.0),
        'cache_v': nrm(ks[3], (DEPTH, DEC_BATCH, PAST_LEN, N_KV_HEADS, HEAD_DIM), 1.0),
        'cache_idx_k': nrm(ks[4], (DEPTH, DEC_BATCH, PAST_LEN, IDX_DIM), 1.0),
        'w_in': nrm(ks[5], (DEPTH, D_MODEL, IN_DIM), D_MODEL ** -0.5),
        'idx_k_g': 1.0 + nrm(ks[6], (DEPTH, IDX_DIM), 0.02),
        'idx_k_b': nrm(ks[7], (DEPTH, IDX_DIM), 0.02),
        'sgu_ln_g': 1.0 + nrm(ks[8], (DEPTH, GMLP_DIM), 0.02),
        'sgu_ln_b': nrm(ks[9], (DEPTH, GMLP_DIM), 0.02),
        'w_s': nrm(ks[10], (DEPTH, GMLP_GROUPS, GMLP_CHUNK, GMLP_CHUNK), 0.5 * GMLP_CHUNK ** -0.5),
        'b_s': 1.0 + nrm(ks[11], (DEPTH, GMLP_GROUPS, GMLP_CHUNK), 0.01),
        'w_pa': nrm(ks[12], (DEPTH, ATTN_DIM, D_MODEL), ATTN_DIM ** -0.5),
        'w_pb': nrm(ks[13], (DEPTH, GMLP_DIM, D_MODEL), GMLP_DIM ** -0.5),
        'w_out': nrm(ks[14], (DEPTH, D_MODEL, D_MODEL), BETA * D_MODEL ** -0.5),
        'ln1_g': 1.0 + nrm(ks[15], (DEPTH, D_MODEL), 0.02),
        'ln1_b': nrm(ks[16], (DEPTH, D_MODEL), 0.02),
        'w_ff1': nrm(ks[17], (DEPTH, D_MODEL, D_FF), D_MODEL ** -0.5),
        'w_ff2': nrm(ks[18], (DEPTH, D_FF, D_MODEL), BETA * D_FF ** -0.5),
        'ln2_g': 1.0 + nrm(ks[19], (DEPTH, D_MODEL), 0.02),
        'ln2_b': nrm(ks[20], (DEPTH, D_MODEL), 0.02),
    }


def reference(x_prompt, x_sample, cache_k, cache_v, cache_idx_k, w_in, idx_k_g, idx_k_b,
              sgu_ln_g, sgu_ln_b, w_s, b_s, w_pa, w_pb, w_out, ln1_g, ln1_b,
              w_ff1, w_ff2, ln2_g, ln2_b):
    t_prompt = x_prompt.shape[1]
    t_sample = x_sample.shape[1]
    past = cache_k.shape[2]
    pos_p = jnp.arange(t_prompt)
    pos_s = past + jnp.arange(t_sample)
    topk_p = min(TOPK_MAX, t_prompt // 4)
    topk_s = min(TOPK_MAX, (past + t_sample) // 4)

    xp, xs = x_prompt, x_sample
    pk, pv, pik, sk, sv, sik, ssv = [], [], [], [], [], [], []
    for l in range(DEPTH):
        q, k, v, qi, ki, wi, u, vg, ga, gb = _mixer_inputs(xp, pos_p, w_in[l], idx_k_g[l], idx_k_b[l])
        o_a = _prompt_attention(q, k, v, qi, ki, wi, topk_p)
        o_b = _sgu_prompt(u, _layer_norm(vg, sgu_ln_g[l], sgu_ln_b[l]), w_s[l], b_s[l])
        xp = _post_block(xp, o_a, o_b, ga, gb, w_pa[l], w_pb[l], w_out[l], ln1_g[l], ln1_b[l],
                         w_ff1[l], w_ff2[l], ln2_g[l], ln2_b[l])
        pk.append(k)
        pv.append(v)
        pik.append(ki)

        q, k, v, qi, ki, wi, u, vg, ga, gb = _mixer_inputs(xs, pos_s, w_in[l], idx_k_g[l], idx_k_b[l])
        k_all = jnp.concatenate([cache_k[l], k], axis=1)
        v_all = jnp.concatenate([cache_v[l], v], axis=1)
        ki_all = jnp.concatenate([cache_idx_k[l], ki], axis=1)
        o_a = _sparse_attend(q, qi, wi, pos_s, k_all, v_all, ki_all, topk_s)
        vn = _layer_norm(vg, sgu_ln_g[l], sgu_ln_b[l])
        o_b = _sgu_sample(u, vn, w_s[l], b_s[l])
        xs = _post_block(xs, o_a, o_b, ga, gb, w_pa[l], w_pb[l], w_out[l], ln1_g[l], ln1_b[l],
                         w_ff1[l], w_ff2[l], ln2_g[l], ln2_b[l])
        sk.append(k)
        sv.append(v)
        sik.append(ki)
        ssv.append(vn)

    return (xp, xs, jnp.stack(pk), jnp.stack(pv), jnp.stack(pik),
            jnp.stack(sk), jnp.stack(sv), jnp.stack(sik), jnp.stack(ssv))
```

```cpp
#include <hip/hip_runtime.h>
#include <hip/hip_cooperative_groups.h>
#include <cstdio>
namespace cg = cooperative_groups;

#ifndef PROBE
#define PROBE 0
#endif
#define LAS __attribute__((address_space(3)))
typedef unsigned short bf16_t;
typedef short bf16x8 __attribute__((ext_vector_type(8)));
typedef float f32x4 __attribute__((ext_vector_type(4)));
typedef float f32x16 __attribute__((ext_vector_type(16)));
typedef unsigned u32x4 __attribute__((ext_vector_type(4)));
typedef unsigned u32x2 __attribute__((ext_vector_type(2)));

constexpr int MP = 32768, MS = 512, MT = 33280, DM = 1024, NPK = 4352, DFF = 4096;
constexpr int LDH = 4096 + 64;
constexpr float ALPHA = 1.41421356237f, LN_EPS = 1e-5f;
constexpr size_t O_Y = 0, O_PK = 34078720, O_PV = 42467328, O_PIK = 50855936, O_SK = 55050240, O_SV = 55181312, O_SIK = 55312384,
                 O_SSV = 55377920, O_END = 55902208;
constexpr size_t W_WIN = 0;
constexpr size_t W_WPA = W_WIN + 2ull * 4352 * 1024 * 2;
constexpr size_t W_WPB = W_WPA + 2ull * 1024 * 512 * 2;
constexpr size_t W_WOUT = W_WPB + 2ull * 1024 * 512 * 2;
constexpr size_t W_FF1 = W_WOUT + 2ull * 1024 * 1024 * 2;
constexpr size_t W_FF2 = W_FF1 + 2ull * 4096 * 1024 * 2;
constexpr size_t W_WSM = W_FF2 + 2ull * LDH * 1024 * 2;
constexpr size_t W_ROPE = W_WSM + 2ull * 4 * 128 * 128 * 2;
constexpr size_t W_XBF = W_ROPE + 4096ull * 16 * 4;
constexpr size_t W_BIG = W_XBF + (size_t)MT * 1024 * 2;
constexpr size_t W_Q = W_BIG;
constexpr size_t W_KP = W_Q + (size_t)MT * 512 * 2;
constexpr size_t W_VP = W_KP + (size_t)MP * 128 * 2;
constexpr size_t W_QI = W_VP + (size_t)MP * 128 * 2;
constexpr size_t W_KIP = W_QI + (size_t)MT * 256 * 2;
constexpr size_t W_KIRAW = W_KIP + (size_t)MP * 64 * 2;
constexpr size_t W_WI = W_KIRAW + (size_t)MT * 64 * 4;
constexpr size_t W_U = W_WI + (size_t)MT * 4 * 4;
constexpr size_t W_VG = W_U + (size_t)MT * 512 * 2;
constexpr size_t W_GA = W_VG + (size_t)MT * 512 * 2;
constexpr size_t W_GB = W_GA + (size_t)MT * 1024 * 2;
constexpr size_t W_BIGEND = W_GB + (size_t)MT * 1024 * 2;
constexpr size_t W_MRG = W_Q;
static_assert((size_t)MT * 1024 * 2 <= W_KIRAW - W_Q, "merged overlay");
constexpr size_t W_H = W_BIG;
static_assert((size_t)MT * LDH * 2 <= W_BIGEND - W_BIG, "H overlay");
constexpr size_t W_KS = W_BIGEND;
constexpr size_t W_VS = W_KS + 2ull * 16 * 2080 * 128 * 2;
constexpr size_t W_KIS = W_VS + 2ull * 16 * 2080 * 128 * 2;
constexpr size_t W_SEL = W_KIS + 2ull * 16 * 2080 * 64 * 2;
constexpr size_t W_OA = W_SEL + (size_t)MT * 256 * 2;
constexpr size_t W_PART = W_OA + (size_t)MT * 512 * 2;
constexpr size_t W_BAR = W_PART + 8ull * MS * 1024 * 4;
constexpr size_t W_END = W_BAR + 16384;

constexpr int LDS_BYTES = 139264 + 16;

struct Params {
  const float *x_prompt, *x_sample, *cache_k, *cache_v, *cache_ik, *w_in, *idx_g, *idx_b, *sgu_g, *sgu_b, *w_s, *b_s, *w_pa, *w_pb, *w_out,
      *ln1_g, *ln1_b, *w_ff1, *w_ff2, *ln2_g, *ln2_b;
  float* out;
  unsigned char* ws;
};

__device__ __forceinline__ unsigned cvt_pk_bf16(float lo, float hi) {
  unsigned r;
  asm volatile("v_cvt_pk_bf16_f32 %0, %1, %2" : "=v"(r) : "v"(lo), "v"(hi));
  return r;
}
template <class T> __device__ __forceinline__ T launder(T p) { asm volatile("" : "+s"(p)); return p; }
typedef const __attribute__((address_space(4))) Params* KP;
__device__ __forceinline__ int otid() { int t = threadIdx.x; asm volatile("" : "+v"(t)); return t; }
__device__ __forceinline__ float bflo(unsigned w) { return __uint_as_float(w << 16); }
__device__ __forceinline__ float bfhi(unsigned w) { return __uint_as_float(w & 0xffff0000u); }
__device__ __forceinline__ float bf2f(bf16_t b) { return __uint_as_float(((unsigned)b) << 16); }

__device__ __forceinline__ size_t kif_off(int key, int li  ) { return ((size_t)(((key >> 5) * 4 + (li >> 2)) * 64 + ((li >> 1) & 1) * 32 + (key & 31))) * 8 + (li & 1) * 4; }
enum { G_Q = 0, G_K, G_V, G_QI, G_KI, G_WI, G_U, G_VG, G_GA, G_GB, G_PAD };
__host__ __device__ __forceinline__ void slot_info(int S, int& grp, int& off) {
  if (S < 16) { grp = G_Q; off = 32 * S; }
  else if (S < 20) { grp = G_K; off = 32 * (S - 16); }
  else if (S < 24) { grp = G_V; off = 32 * (S - 20); }
  else if (S < 32) { grp = G_QI; off = 32 * (S - 24); }
  else if (S < 40) {
    if (S == 32) { grp = G_KI; off = 0; }
    else if (S == 33) { grp = G_WI; off = 0; }
    else if (S == 34) { grp = G_U; off = 0; }
    else if (S == 35) { grp = G_U; off = 32; }
    else if (S == 36) { grp = G_KI; off = 32; }
    else { grp = G_U; off = 32 * (S - 35); }
  }
  else if (S < 51) { grp = G_U; off = 32 * (S - 35); }
  else if (S < 67) { grp = G_VG; off = 32 * (S - 51); }
  else if (S < 99) { grp = G_GA; off = 32 * (S - 67); }
  else if (S < 131) { grp = G_GB; off = 32 * (S - 99); }
  else { grp = G_PAD; off = 0; }
}
__device__ __forceinline__ int win_orig_col(int p) {
  int grp, off;
  slot_info(p >> 5, grp, off);
  const int c = p & 31;
  switch (grp) {
    case G_Q: return off + c;
    case G_K: return 512 + off + c;
    case G_V: return 640 + off + c;
    case G_QI: return 768 + off + c;
    case G_KI: return 1024 + off + c;
    case G_WI: return c < 4 ? 1088 + c : -1;
    case G_U: return 1092 + off + c;
    case G_VG: return 1604 + off + c;
    case G_GA: return 2116 + off + c;
    case G_GB: return 3140 + off + c;
    default: return -1;
  }
}

namespace pg8 {
constexpr int BM = 256, BK = 64, HALF = 128, HTB = HALF * BK * 2, STAGE_BYTES = 8 * HTB, NXCD = 8, WGM = 8;
__host__ __device__ __forceinline__ int lds_byte(int r, int c) {
  const int st = (r >> 4) * 2 + (c >> 5), rr = r & 15, cc = c & 31, ob = rr * 64 + cc * 2;
  return st * 1024 + (ob ^ (((ob >> 9) & 1) << 5));
}
__host__ __device__ __forceinline__ void stage_rc(int b, int& R, int& C) {
  const int st = b / 1024, sb = b % 1024, swz = sb ^ (((sb >> 9) & 1) << 5);
  R = (st >> 1) * 16 + swz / 64;
  C = (st & 1) * 32 + (swz % 64) / 2;
}
__host__ __device__ __forceinline__ int perm32(int rho) { const int n = rho >> 4, i = rho & 15; return 8 * (i >> 2) + 4 * n + (i & 3); }
struct Unit { int pm, pn, kt0, nt, split, which; };
struct Gemm { const bf16_t* A; const bf16_t* Bt; int M, N, K, lda, ldb; const bf16_t* A2; const bf16_t* Bt2; };
struct StaticOrder {
  int nM, nN, nwg, nextra, splits, ntfull, G, c, dual;
  __device__ void init(int N, int K, int splits_, int G_, int c_) {
    nM = MP / BM; nN = N / BM; nwg = nM * nN; splits = splits_ > 0 ? splits_ : 1; nextra = 2 * nN * splits_; ntfull = K / BK; G = G_; c = c_; dual = 0;
  }
  __device__ bool next(int i, Unit& u) const {
    const long L = (long)(i >> dual) * G + c;
    u.which = dual ? (i & 1) : 0;
    if (L < nwg) {
      int wgid = (int)L;
      { const int q = nwg / NXCD, r = nwg % NXCD, xcd = wgid % NXCD, off = wgid / NXCD; wgid = (xcd < r ? xcd * (q + 1) : r * (q + 1) + (xcd - r) * q) + off; }
      const int nig = WGM * nN, gid = wgid / nig, fm = gid * WGM, gsz = (nM - fm) < WGM ? (nM - fm) : WGM;
      u.pm = fm + ((wgid % nig) % gsz);
      u.pn = (wgid % nig) / gsz;
      u.kt0 = 0; u.nt = ntfull; u.split = 0;
      return true;
    }
    const int j = (int)(L - nwg);
    if (j >= nextra) return false;
    const int per_panel = nN * splits;
    u.pm = nM + j / per_panel;
    const int rem = j % per_panel;
    u.pn = rem / splits;
    u.nt = ntfull / splits;
    u.kt0 = (rem % splits) * u.nt;
    u.split = splits > 1 ? 1 : 0;
    return true;
  }
};

template <class Epi>
__device__ __forceinline__ void gemm_phase(LAS unsigned char* lds, const Gemm g, const StaticOrder& S, const Epi& E) {
  const int tid = otid(), wid = __builtin_amdgcn_readfirstlane(tid >> 6), lane = tid & 63, wr = wid >> 2, wc = wid & 3, fr = lane & 15, fq = lane >> 4;
  const int K = g.K;
  unsigned voffA[2], voffB[2];
#pragma unroll
  for (int i = 0; i < 2; ++i) {
    int R, C;
    stage_rc(tid * 16 + i * 8192, R, C);
    const int Rb = Epi::PERM ? ((R & ~31) + perm32(R & 31)) : R;
    voffA[i] = (unsigned)(R * g.lda + C) * 2u;
    voffB[i] = (unsigned)(Rb * g.ldb + C) * 2u;
  }
  const size_t kstep = (size_t)(BK * 2);
  const size_t hstepA = (size_t)HALF * g.lda * 2, hstepB = (size_t)HALF * g.ldb * 2;
  const size_t tstepA = 2 * hstepA, tstepB = 2 * hstepB;
  const unsigned ldsw = (unsigned)wid * 1024u;
  const int aoff = lds_byte(wr * 64 + fr, fq * 8), boff = lds_byte(wc * 32 + fr, fq * 8);
#define PG8_SA(b, h) (((b) * 2 + (h)) * HTB)
#define PG8_SB(b, h) ((4 + (b) * 2 + (h)) * HTB)
#define PG8_STAGE(bufoff, gbase, voff) do { _Pragma("unroll") for (int _i = 0; _i < 2; ++_i) \
    __builtin_amdgcn_global_load_lds((const unsigned*)((const char*)(gbase) + (voff)[_i]), (LAS unsigned*)(lds + (bufoff) + ldsw + _i * 8192), 16, 0, 0); } while (0)
#define PG8_LDA(dst, b, h) do { _Pragma("unroll") for (int m = 0; m < 4; ++m) _Pragma("unroll") for (int k = 0; k < 2; ++k) dst[m][k] = *(const LAS bf16x8*)(lds + PG8_SA(b, h) + aoff + m * 2048 + k * 1024); } while (0)
#define PG8_LDB(dst, b, h) do { _Pragma("unroll") for (int n = 0; n < 2; ++n) _Pragma("unroll") for (int k = 0; k < 2; ++k) dst[n][k] = *(const LAS bf16x8*)(lds + PG8_SB(b, h) + boff + n * 2048 + k * 1024); } while (0)
#define PG8_MMA(ai, bj, At, Bt) do { __builtin_amdgcn_s_setprio(1); _Pragma("unroll") for (int m = 0; m < 4; ++m) _Pragma("unroll") for (int n = 0; n < 2; ++n) _Pragma("unroll") for (int k = 0; k < 2; ++k) \
    acc[ai][bj][m][n] = __builtin_amdgcn_mfma_f32_16x16x32_bf16(Bt[n][k], At[m][k], acc[ai][bj][m][n], 0, 0, 0); __builtin_amdgcn_s_setprio(0); } while (0)
#define PG8_WAIT_V(n) asm volatile("s_waitcnt vmcnt(" #n ")" ::: "memory")
#define PG8_WAIT_L(n) asm volatile("s_waitcnt lgkmcnt(" #n ")" ::: "memory")
#define PG8_BAR __builtin_amdgcn_s_barrier()
#define PG8_SCHED __builtin_amdgcn_sched_barrier(0)
  Unit cur, nxt;
  int ui = 0;
  if (!S.next(0, cur)) return;
  f32x4 acc[2][2][4][2];
#pragma unroll
  for (int a = 0; a < 2; ++a)
#pragma unroll
    for (int b = 0; b < 2; ++b)
#pragma unroll
      for (int m = 0; m < 4; ++m)
#pragma unroll
        for (int n = 0; n < 2; ++n) acc[a][b][m][n] = (f32x4){0.f, 0.f, 0.f, 0.f};
  bf16x8 At[4][2], B0[2][2], B1[2][2];
  const char* cA = (const char*)(cur.which ? g.A2 : g.A) + (size_t)cur.pm * tstepA + (size_t)cur.kt0 * kstep;
  const char* cB = (const char*)(cur.which ? g.Bt2 : g.Bt) + (size_t)cur.pn * tstepB + (size_t)cur.kt0 * kstep;
  PG8_STAGE(PG8_SB(0, 0), cB, voffB); PG8_STAGE(PG8_SA(0, 0), cA, voffA); PG8_STAGE(PG8_SB(0, 1), cB + hstepB, voffB); PG8_STAGE(PG8_SA(0, 1), cA + hstepA, voffA);
  if (wr == 1) PG8_BAR;
  PG8_WAIT_V(4); PG8_BAR;
  PG8_STAGE(PG8_SB(1, 0), cB + kstep, voffB); PG8_STAGE(PG8_SA(1, 0), cA + kstep, voffA); PG8_STAGE(PG8_SB(1, 1), cB + hstepB + kstep, voffB);
  PG8_WAIT_V(6); PG8_BAR;
  for (;;) {
    const bool has_next = S.next(ui + 1, nxt);
    const char* nA = has_next ? (const char*)(nxt.which ? g.A2 : g.A) + (size_t)nxt.pm * tstepA + (size_t)nxt.kt0 * kstep : cA;
    const char* nB = has_next ? (const char*)(nxt.which ? g.Bt2 : g.Bt) + (size_t)nxt.pn * tstepB + (size_t)nxt.kt0 * kstep : cB;
    const int nt = cur.nt;
    for (int t = 0; t < nt; t += 2) {
      const bool last = (t == nt - 2);
      const char* a1 = cA + (size_t)(t + 1) * kstep;
      const char* a2 = last ? nA : cA + (size_t)(t + 2) * kstep;
      const char* b2 = last ? nB : cB + (size_t)(t + 2) * kstep;
      const char* a3 = a2 + kstep;
      const char* b3 = b2 + kstep;
      PG8_LDB(B0, 0, 0); PG8_SCHED; PG8_LDA(At, 0, 0); PG8_STAGE(PG8_SA(1, 1), a1 + hstepA, voffA);
      PG8_WAIT_L(8); PG8_BAR; PG8_WAIT_L(0); PG8_MMA(0, 0, At, B0); PG8_BAR; PG8_SCHED;
      PG8_LDB(B1, 0, 1); PG8_STAGE(PG8_SB(0, 0), b2, voffB);
      PG8_BAR; PG8_WAIT_L(0); PG8_MMA(0, 1, At, B1); PG8_BAR;
      PG8_LDA(At, 0, 1); PG8_STAGE(PG8_SA(0, 0), a2, voffA);
      PG8_BAR; PG8_WAIT_L(0); PG8_MMA(1, 0, At, B0); PG8_BAR; PG8_SCHED;
      PG8_STAGE(PG8_SB(0, 1), b2 + hstepB, voffB);
      PG8_WAIT_V(6); PG8_BAR; PG8_MMA(1, 1, At, B1); PG8_BAR;
      PG8_LDB(B0, 1, 0); PG8_SCHED; PG8_LDA(At, 1, 0); PG8_STAGE(PG8_SA(0, 1), a2 + hstepA, voffA);
      PG8_WAIT_L(8); PG8_BAR; PG8_WAIT_L(0); PG8_MMA(0, 0, At, B0); PG8_BAR; PG8_SCHED;
      PG8_LDB(B1, 1, 1); PG8_STAGE(PG8_SB(1, 0), b3, voffB);
      PG8_BAR; PG8_WAIT_L(0); PG8_MMA(0, 1, At, B1); PG8_BAR;
      PG8_LDA(At, 1, 1); PG8_STAGE(PG8_SA(1, 0), a3, voffA);
      PG8_BAR; PG8_WAIT_L(0); PG8_MMA(1, 0, At, B0); PG8_BAR; PG8_SCHED;
      PG8_STAGE(PG8_SB(1, 1), b3 + hstepB, voffB);
      PG8_WAIT_V(6); PG8_BAR; PG8_MMA(1, 1, At, B1); PG8_BAR;
    }
    E(acc, cur, wr, wc, fr, fq);
    if (!has_next) break;
#pragma unroll
    for (int a = 0; a < 2; ++a)
#pragma unroll
      for (int b = 0; b < 2; ++b)
#pragma unroll
        for (int m = 0; m < 4; ++m)
#pragma unroll
          for (int n = 0; n < 2; ++n) acc[a][b][m][n] = (f32x4){0.f, 0.f, 0.f, 0.f};
    cur = nxt; cA = nA; cB = nB; ++ui;
  }
  PG8_WAIT_V(0);
  if (wr == 0) PG8_BAR;
  PG8_BAR;
#undef PG8_SA
#undef PG8_SB
#undef PG8_STAGE
#undef PG8_LDA
#undef PG8_LDB
#undef PG8_MMA
#undef PG8_WAIT_V
#undef PG8_WAIT_L
#undef PG8_BAR
#undef PG8_SCHED
}
}
using pg8::Unit;

struct EpiIn {
  static constexpr bool PERM = true;
  int l;
  float* out;
  unsigned char* ws;
  static __device__ __forceinline__ void rot_mul(f32x4 (&a)[4], const f32x4 (&b)[4]) {
#pragma unroll
    for (int e = 0; e < 4; ++e) {
      const f32x4 x = a[e], y = b[e];
      a[e] = (f32x4){x[0] * y[0] - x[1] * y[1], x[1] * y[0] + x[0] * y[1], x[2] * y[2] - x[3] * y[3], x[3] * y[2] + x[2] * y[3]};
    }
  }
  template <int CAT>
  __device__ __forceinline__ void slot(const f32x4 (&acc)[2][2][4][2], int bj, int r00, int p0, bool sunit, int fq, int c0, bf16_t* bdst, int bstride, float* fdst,
                                       float scale) const {
    const float* rope = (const float*)(ws + W_ROPE);
    const f32x4 r16[4] = {{-9.576594803e-01f, -2.879033167e-01f, -9.992462583e-01f, 3.881900626e-02f}, {8.243765167e-01f, 5.660418348e-01f, 9.932003015e-01f, 1.164180448e-01f}, {9.997440109e-01f, 2.262548617e-02f, 9.999903729e-01f, 4.387956933e-03f}, {9.999996380e-01f, 8.509272148e-04f, 9.999999864e-01f, 1.650141632e-04f}};
#pragma unroll
    for (int ai = 0; ai < 2; ++ai) {
      f32x4 csa[4];
      if (CAT == 0) {
        const int pa = sunit ? p0 : p0 + 128 * ai;
#pragma unroll
        for (int e = 0; e < 4; ++e) csa[e] = *(const f32x4*)(rope + (size_t)pa * 16 + e * 4);
      }
#pragma unroll
      for (int m = 0; m < 4; ++m) {
        const int r = r00 + ai * 128 + m * 16;
        const int sr = r - MP;
        float v[8];
#pragma unroll
        for (int e = 0; e < 4; ++e) {
          v[e] = bj == 0 ? acc[ai][0][m][0][e] : acc[ai][1][m][0][e];
          v[4 + e] = bj == 0 ? acc[ai][0][m][1][e] : acc[ai][1][m][1][e];
        }
        if (CAT == 0) {
          if (m == 2 && sunit) {
#pragma unroll
            for (int e = 0; e < 4; ++e) csa[e] = *(const f32x4*)(rope + (size_t)p0 * 16 + e * 4);
          }
          float pr[8];
#pragma unroll
          for (int e = 0; e < 8; ++e) pr[e] = __shfl_xor(v[e], 16);
          if (fq < 2) {
#pragma unroll
            for (int e2 = 0; e2 < 4; ++e2) {
              const f32x4 t = csa[e2];
              if (fq == 0) {
                v[2 * e2] = v[2 * e2] * t[0] - pr[2 * e2] * t[1];
                v[2 * e2 + 1] = v[2 * e2 + 1] * t[2] - pr[2 * e2 + 1] * t[3];
              } else {
                v[2 * e2] = pr[2 * e2] * t[1] + v[2 * e2] * t[0];
                v[2 * e2 + 1] = pr[2 * e2 + 1] * t[3] + v[2 * e2 + 1] * t[2];
              }
            }
          }
          if (m < 3) rot_mul(csa, r16);
        }
        if (CAT == 2) {
          unsigned q[8];
#pragma unroll
          for (int e = 0; e < 8; ++e) q[e] = (unsigned)(__frcp_rn(1.f + __expf(-v[e])) * 255.f + 0.5f);
          u32x2 w8;
          w8[0] = q[0] | (q[1] << 8) | (q[2] << 16) | (q[3] << 24);
          w8[1] = q[4] | (q[5] << 8) | (q[6] << 16) | (q[7] << 24);
          *(u32x2*)((unsigned char*)bdst + (size_t)r * 1024 + c0) = w8;
          continue;
        }
        if (CAT == 3) {
          float* d = (float*)(ws + W_KIRAW) + (size_t)r * 64 + c0;
          *(f32x4*)d = (f32x4){v[0], v[1], v[2], v[3]};
          *(f32x4*)(d + 4) = (f32x4){v[4], v[5], v[6], v[7]};
        } else if (CAT == 4) {
          if (fq == 0) *(f32x4*)((float*)(ws + W_WI) + (size_t)r * 4) = (f32x4){v[0] * 0.5f, v[1] * 0.5f, v[2] * 0.5f, v[3] * 0.5f};
        } else {
          u32x4 w;
#pragma unroll
          for (int e = 0; e < 4; ++e) w[e] = cvt_pk_bf16(v[2 * e] * scale, v[2 * e + 1] * scale);
          size_t brow = (size_t)r;
          if (fdst && sunit) brow = (size_t)(l * 16 + (sr >> 5)) * 2080 + 2048 + (sr & 31);
          *(u32x4*)(bdst + brow * bstride + c0) = w;
          if (fdst) {
            float* fp = fdst + ((size_t)(sunit ? l * MS + sr : l * MP + r)) * 128 + c0;
            *(f32x4*)fp = (f32x4){v[0], v[1], v[2], v[3]};
            *(f32x4*)(fp + 4) = (f32x4){v[4], v[5], v[6], v[7]};
          }
        }
        if (CAT == 0) __builtin_amdgcn_sched_barrier(0);
      }
    }
  }
  __device__ __forceinline__ void operator()(const f32x4 (&acc)[2][2][4][2], const Unit& u, int wr, int wc, int fr, int fq) const {
    const bool sunit = u.pm >= MP / 256;
    const int r00 = u.pm * 256 + wr * 64 + fr;
    const int p0 = sunit ? 2048 + fr : (r00 & 4095);
#pragma unroll
    for (int bj = 0; bj < 2; ++bj) {
      int grp, off;
      slot_info(u.pn * 8 + bj * 4 + wc, grp, off);
      if (grp == G_PAD) continue;
      const int c0 = off + 8 * fq;
      const bool dorope = (grp == G_Q || grp == G_K || grp == G_QI) && ((off & 63) == 0);
      const float scale = (grp == G_Q || grp == G_QI) ? 0.125f : 1.0f;
      bf16_t* bdst;
      int bstride;
      float* fdst = nullptr;
      switch (grp) {
        case G_Q: bdst = (bf16_t*)(ws + W_Q); bstride = 512; break;
        case G_QI: bdst = (bf16_t*)(ws + W_QI); bstride = 256; break;
        case G_K: bdst = (bf16_t*)(ws + (sunit ? W_KS : W_KP)); bstride = 128; fdst = out + (sunit ? O_SK : O_PK); break;
        case G_V: bdst = (bf16_t*)(ws + (sunit ? W_VS : W_VP)); bstride = 128; fdst = out + (sunit ? O_SV : O_PV); break;
        case G_U: bdst = (bf16_t*)(ws + W_U); bstride = 512; break;
        case G_VG: bdst = (bf16_t*)(ws + W_VG); bstride = 512; break;
        case G_GA: bdst = (bf16_t*)(ws + W_GA); bstride = 1024; break;
        case G_GB: bdst = (bf16_t*)(ws + W_GB); bstride = 1024; break;
        default: bdst = nullptr; bstride = 0; break;
      }
      if (dorope) slot<0>(acc, bj, r00, p0, sunit, fq, c0, bdst, bstride, fdst, scale);
      else if (grp == G_GA || grp == G_GB) slot<2>(acc, bj, r00, p0, sunit, fq, c0, bdst, bstride, fdst, scale);
      else if (grp == G_KI) slot<3>(acc, bj, r00, p0, sunit, fq, c0, bdst, bstride, fdst, scale);
      else if (grp == G_WI) slot<4>(acc, bj, r00, p0, sunit, fq, c0, bdst, bstride, fdst, scale);
      else slot<1>(acc, bj, r00, p0, sunit, fq, c0, bdst, bstride, fdst, scale);
    }
  }
};

struct EpiGate {
  static constexpr bool PERM = true;
  const unsigned char* ga;
  const unsigned char* gb;
  bf16_t* mrg;
  __device__ __forceinline__ void operator()(const f32x4 (&acc)[2][2][4][2], const Unit& u, int wr, int wc, int fr, int fq) const {
    const unsigned char* gate = u.which ? gb : ga;
#pragma unroll
    for (int ai = 0; ai < 2; ++ai) {
      u32x2 gw[4][2];
      u32x4 pw[4][2];
#pragma unroll
      for (int m = 0; m < 4; ++m)
#pragma unroll
        for (int bj = 0; bj < 2; ++bj) {
          const size_t o = (size_t)(u.pm * 256 + ai * 128 + wr * 64 + m * 16 + fr) * 1024 + u.pn * 256 + bj * 128 + wc * 32 + 8 * fq;
          gw[m][bj] = *(const u32x2*)(gate + o);
          pw[m][bj] = (u32x4){0u, 0u, 0u, 0u};
          if (u.which) pw[m][bj] = *(const u32x4*)(mrg + o);
        }
#pragma unroll
      for (int m = 0; m < 4; ++m)
#pragma unroll
        for (int bj = 0; bj < 2; ++bj) {
          const size_t o = (size_t)(u.pm * 256 + ai * 128 + wr * 64 + m * 16 + fr) * 1024 + u.pn * 256 + bj * 128 + wc * 32 + 8 * fq;
          float v[8];
#pragma unroll
          for (int e = 0; e < 8; ++e) v[e] = (float)((gw[m][bj][e >> 2] >> (8 * (e & 3))) & 0xffu) * (1.f / 255.f) * acc[ai][bj][m][e >> 2][e & 3];
#pragma unroll
          for (int e = 0; e < 4; ++e) { v[2 * e] += bflo(pw[m][bj][e]); v[2 * e + 1] += bfhi(pw[m][bj][e]); }
          u32x4 w;
#pragma unroll
          for (int e = 0; e < 4; ++e) w[e] = cvt_pk_bf16(v[2 * e], v[2 * e + 1]);
          *(u32x4*)(mrg + o) = w;
        }
    }
  }
};

struct EpiRes {
  static constexpr bool PERM = false;
  const float* xp;
  const bf16_t* xb;
  float* R;
  float* part;
  __device__ __forceinline__ void operator()(const f32x4 (&acc)[2][2][4][2], const Unit& u, int wr, int wc, int fr, int fq) const {
    if (u.split) {
      float* pbase = part + (size_t)(u.kt0 / u.nt) * MS * 1024;
#pragma unroll
      for (int ai = 0; ai < 2; ++ai)
#pragma unroll
        for (int m = 0; m < 4; ++m) {
          float* orow = pbase + (size_t)(u.pm * 256 + ai * 128 + wr * 64 + m * 16 + fr - MP) * 1024;
#pragma unroll
          for (int bj = 0; bj < 2; ++bj)
#pragma unroll
            for (int n = 0; n < 2; ++n) *(f32x4*)(orow + u.pn * 256 + bj * 128 + wc * 32 + 16 * n + 4 * fq) = acc[ai][bj][m][n];
        }
      return;
    }
    if (xp) {
#pragma unroll
      for (int ai = 0; ai < 2; ++ai)
#pragma unroll
        for (int mp = 0; mp < 2; ++mp) {
          f32x4 xr[2][2][2];
#pragma unroll
          for (int mm = 0; mm < 2; ++mm)
#pragma unroll
            for (int bj = 0; bj < 2; ++bj)
#pragma unroll
              for (int n = 0; n < 2; ++n)
                xr[mm][bj][n] = *(const f32x4*)(xp + (size_t)(u.pm * 256 + ai * 128 + wr * 64 + (mp * 2 + mm) * 16 + fr) * 1024 + u.pn * 256 + bj * 128 + wc * 32 + 16 * n + 4 * fq);
#pragma unroll
          for (int mm = 0; mm < 2; ++mm)
#pragma unroll
            for (int bj = 0; bj < 2; ++bj)
#pragma unroll
              for (int n = 0; n < 2; ++n) {
                const size_t o = (size_t)(u.pm * 256 + ai * 128 + wr * 64 + (mp * 2 + mm) * 16 + fr) * 1024 + u.pn * 256 + bj * 128 + wc * 32 + 16 * n + 4 * fq;
                *(f32x4*)(R + o) = xr[mm][bj][n] * ALPHA + acc[ai][bj][mp * 2 + mm][n];
              }
        }
    } else {
#pragma unroll
      for (int ai = 0; ai < 2; ++ai) {
        u32x2 xr[4][2][2];
#pragma unroll
        for (int m = 0; m < 4; ++m)
#pragma unroll
          for (int bj = 0; bj < 2; ++bj)
#pragma unroll
            for (int n = 0; n < 2; ++n)
              xr[m][bj][n] = *(const u32x2*)(xb + (size_t)(u.pm * 256 + ai * 128 + wr * 64 + m * 16 + fr) * 1024 + u.pn * 256 + bj * 128 + wc * 32 + 16 * n + 4 * fq);
#pragma unroll
        for (int m = 0; m < 4; ++m)
#pragma unroll
          for (int bj = 0; bj < 2; ++bj)
#pragma unroll
            for (int n = 0; n < 2; ++n) {
              const size_t o = (size_t)(u.pm * 256 + ai * 128 + wr * 64 + m * 16 + fr) * 1024 + u.pn * 256 + bj * 128 + wc * 32 + 16 * n + 4 * fq;
              const u32x2 xw = xr[m][bj][n];
              const f32x4 x = (f32x4){bflo(xw[0]), bfhi(xw[0]), bflo(xw[1]), bfhi(xw[1])};
              *(f32x4*)(R + o) = x * ALPHA + acc[ai][bj][m][n];
            }
      }
    }
  }
};

struct EpiFF1 {
  static constexpr bool PERM = true;
  bf16_t* H;
  __device__ __forceinline__ void operator()(const f32x4 (&acc)[2][2][4][2], const Unit& u, int wr, int wc, int fr, int fq) const {
#pragma unroll
    for (int ai = 0; ai < 2; ++ai)
#pragma unroll
      for (int m = 0; m < 4; ++m) {
        const int r = u.pm * 256 + ai * 128 + wr * 64 + m * 16 + fr;
#pragma unroll
        for (int bj = 0; bj < 2; ++bj) {
          float v[8];
#pragma unroll
          for (int e = 0; e < 4; ++e) {
            const float a = fmaxf(acc[ai][bj][m][0][e], 0.f), b = fmaxf(acc[ai][bj][m][1][e], 0.f);
            v[e] = a * a; v[4 + e] = b * b;
          }
          u32x4 w;
#pragma unroll
          for (int e = 0; e < 4; ++e) w[e] = cvt_pk_bf16(v[2 * e], v[2 * e + 1]);
          *(u32x4*)(H + (size_t)r * LDH + u.pn * 256 + bj * 128 + wc * 32 + 8 * fq) = w;
        }
      }
  }
};

__device__ __forceinline__ void cvt_rows(const float* __restrict__ src, bf16_t* __restrict__ dst, size_t n4, size_t gtid, size_t gn) {
  for (size_t i0 = gtid; i0 < n4; i0 += 4 * gn) {
    f32x4 v[4];
#pragma unroll
    for (int q = 0; q < 4; ++q) { const size_t i = i0 + q * gn; v[q] = i < n4 ? *(const f32x4*)(src + i * 4) : (f32x4){0.f, 0.f, 0.f, 0.f}; }
#pragma unroll
    for (int q = 0; q < 4; ++q) {
      const size_t i = i0 + q * gn;
      if (i < n4) { u32x2 w; w[0] = cvt_pk_bf16(v[q][0], v[q][1]); w[1] = cvt_pk_bf16(v[q][2], v[q][3]); *(u32x2*)(dst + i * 4) = w; }
    }
  }
}

struct TTile { const float* src; bf16_t* dst; int ldsrc, K, k0, n0; bool winmap; };
__device__ __forceinline__ TTile prep_tile(KP kp, unsigned char* ws, int j) {
  TTile t;
  t.winmap = false;
  int jj = j;
  if (jj < 2176) {
    const int l = jj / 1088, q = jj % 1088;
    t.src = kp->w_in + (size_t)l * 1024 * 4164; t.ldsrc = 4164; t.dst = (bf16_t*)(ws + W_WIN) + (size_t)l * 4352 * 1024; t.K = 1024; t.n0 = (q / 16) * 64; t.k0 = (q % 16) * 64; t.winmap = true;
    return t;
  }
  jj -= 2176;
  if (jj < 512) {
    const int which = jj / 256, t2 = jj % 256, l = t2 / 128, q = t2 % 128;
    t.src = (which ? kp->w_pb : kp->w_pa) + (size_t)l * 512 * 1024; t.ldsrc = 1024; t.dst = (bf16_t*)(ws + (which ? W_WPB : W_WPA)) + (size_t)l * 1024 * 512; t.K = 512; t.n0 = (q / 8) * 64; t.k0 = (q % 8) * 64;
    return t;
  }
  jj -= 512;
  if (jj < 512) {
    const int l = jj / 256, q = jj % 256;
    t.src = kp->w_out + (size_t)l * 1024 * 1024; t.ldsrc = 1024; t.dst = (bf16_t*)(ws + W_WOUT) + (size_t)l * 1024 * 1024; t.K = 1024; t.n0 = (q / 16) * 64; t.k0 = (q % 16) * 64;
    return t;
  }
  jj -= 512;
  if (jj < 2048) {
    const int l = jj / 1024, q = jj % 1024;
    t.src = kp->w_ff1 + (size_t)l * 1024 * 4096; t.ldsrc = 4096; t.dst = (bf16_t*)(ws + W_FF1) + (size_t)l * 4096 * 1024; t.K = 1024; t.n0 = (q / 16) * 64; t.k0 = (q % 16) * 64;
    return t;
  }
  jj -= 2048;
  {
    const int l = jj / 1024, q = jj % 1024;
    t.src = kp->w_ff2 + (size_t)l * 4096 * 1024; t.ldsrc = 1024; t.dst = (bf16_t*)(ws + W_FF2) + (size_t)l * 1024 * LDH; t.K = LDH; t.n0 = (q / 64) * 64; t.k0 = (q % 64) * 64;
  }
  return t;
}
__device__ __forceinline__ void phase_prep(KP kp, unsigned char* shm) {
  kp = launder(kp);
  float* tl = (float*)shm;
  const int bid = blockIdx.x, nb = gridDim.x, tid = otid();
  unsigned char* ws = kp->ws;
  for (int j0 = bid * 4; j0 < 7296; j0 += nb * 4) {
    float v[4][8];
#pragma unroll
    for (int q = 0; q < 4; ++q) {
      const TTile t = prep_tile(kp, ws, j0 + q);
#pragma unroll
      for (int e = 0; e < 8; ++e) {
        const int idx = tid + e * 512, r = idx >> 6, c = idx & 63;
        const int oc = t.winmap ? win_orig_col(t.n0 + c) : (t.n0 + c);
        v[q][e] = oc >= 0 ? t.src[(size_t)(t.k0 + r) * t.ldsrc + oc] : 0.f;
      }
    }
#pragma unroll
    for (int q = 0; q < 4; ++q)
#pragma unroll
      for (int e = 0; e < 8; ++e) {
        const int idx = tid + e * 512, r = idx >> 6, c = idx & 63;
        tl[q * 4160 + c * 65 + r] = v[q][e];
      }
    __syncthreads();
#pragma unroll
    for (int q = 0; q < 4; ++q) {
      const TTile t = prep_tile(kp, ws, j0 + q);
#pragma unroll
      for (int e = 0; e < 4; ++e) {
        const int idx = tid + e * 512, n = idx >> 5, kk = (idx & 31) * 2;
        *(unsigned*)(t.dst + (size_t)(t.n0 + n) * t.K + t.k0 + kk) = cvt_pk_bf16(tl[q * 4160 + n * 65 + kk], tl[q * 4160 + n * 65 + kk + 1]);
      }
    }
    __syncthreads();
  }
  const size_t gtid = (size_t)bid * 512 + tid, gn = (size_t)nb * 512;
  cvt_rows(kp->x_prompt, (bf16_t*)(ws + W_XBF), (size_t)MP * 256, gtid, gn);
  cvt_rows(kp->x_sample, (bf16_t*)(ws + W_XBF) + (size_t)MP * 1024, (size_t)MS * 256, gtid, gn);
  for (size_t i = gtid; i < (size_t)MS * 256; i += gn)
    *(f32x4*)(kp->out + O_Y + (size_t)MP * 1024 + i * 4) = *(const f32x4*)(kp->x_sample + i * 4) * ALPHA;
  for (size_t i0 = gtid; i0 < 2ull * 16 * 2048 * 32; i0 += 4 * gn) {
    f32x4 a[4], b[4];
#pragma unroll
    for (int q = 0; q < 4; ++q) {
      const size_t i = i0 + q * gn;
      const bool ok = i < 2ull * 16 * 2048 * 32;
      a[q] = ok ? *(const f32x4*)(kp->cache_k + i * 4) : (f32x4){0.f, 0.f, 0.f, 0.f};
      b[q] = ok ? *(const f32x4*)(kp->cache_v + i * 4) : (f32x4){0.f, 0.f, 0.f, 0.f};
    }
#pragma unroll
    for (int q = 0; q < 4; ++q) {
      const size_t i = i0 + q * gn;
      if (i < 2ull * 16 * 2048 * 32) {
        const size_t row = i >> 5, c4 = i & 31, lsb = row >> 11, rr = row & 2047;
        const size_t d = (lsb * 2080 + rr) * 128 + c4 * 4;
        u32x2 w;
        w[0] = cvt_pk_bf16(a[q][0], a[q][1]); w[1] = cvt_pk_bf16(a[q][2], a[q][3]);
        *(u32x2*)((bf16_t*)(ws + W_KS) + d) = w;
        w[0] = cvt_pk_bf16(b[q][0], b[q][1]); w[1] = cvt_pk_bf16(b[q][2], b[q][3]);
        *(u32x2*)((bf16_t*)(ws + W_VS) + d) = w;
      }
    }
  }
  for (size_t i0 = gtid; i0 < 2ull * 16 * 2048 * 16; i0 += 4 * gn) {
    f32x4 a[4];
#pragma unroll
    for (int q = 0; q < 4; ++q) { const size_t i = i0 + q * gn; a[q] = i < 2ull * 16 * 2048 * 16 ? *(const f32x4*)(kp->cache_ik + i * 4) : (f32x4){0.f, 0.f, 0.f, 0.f}; }
#pragma unroll
    for (int q = 0; q < 4; ++q) {
      const size_t i = i0 + q * gn;
      if (i < 2ull * 16 * 2048 * 16) {
        const size_t row = i >> 4, c4 = i & 15, lsb = row >> 11, rr = row & 2047;
        u32x2 w;
        w[0] = cvt_pk_bf16(a[q][0], a[q][1]); w[1] = cvt_pk_bf16(a[q][2], a[q][3]);
        *(u32x2*)((bf16_t*)(ws + W_KIS) + lsb * 2080 * 64 + kif_off((int)rr, (int)c4)) = w;
      }
    }
  }
  for (size_t i = gtid; i < 4096 * 8; i += gn) {
    const int pos = (int)(i >> 3), fi = (int)(i & 7);
    const float fr[8] = {1.0f, 0.1939227432012558f, 0.03760603070259094f, 0.007292664609849453f, 0.0014142135623842478f, 0.00027424818836152554f,
                         5.3182957344688475e-05f, 1.0313385246263351e-05f};
    float f = fr[0];
#pragma unroll
    for (int q = 1; q < 8; ++q) f = (fi == q) ? fr[q] : f;
    const float ang = (float)pos * f;
    double rev = (double)ang * 0.15915494309189535;
    rev -= floor(rev);
    const float t = (float)rev;
    float* d = (float*)(ws + W_ROPE) + i * 2;
    d[0] = __builtin_amdgcn_cosf(t);
    d[1] = __builtin_amdgcn_sinf(t);
  }
  for (size_t i = gtid; i < 2ull * 4 * 128 * 128; i += gn) {
    const int s = (int)(i & 127), t = (int)((i >> 7) & 127);
    const float v = s <= t ? kp->w_s[i] : 0.f;
    ((bf16_t*)(ws + W_WSM))[i] = (bf16_t)(cvt_pk_bf16(v, 0.f) & 0xffffu);
  }
}

__device__ __forceinline__ void phase_fix(KP kp, int l, unsigned char* shm) {
  kp = launder(kp);
  const int tid = otid(), lane = tid & 63, w = tid >> 6, bid = blockIdx.x, nb = gridDim.x;
  unsigned char* ws = kp->ws;
  const float* rope = (const float*)(ws + W_ROPE);
  {
    const int li = tid & 15;
    const f32x4 gg = *(const f32x4*)(kp->idx_g + l * 64 + li * 4), bb = *(const f32x4*)(kp->idx_b + l * 64 + li * 4);
    for (int rb = bid * 32; rb < MT; rb += nb * 32) {
      const int r = rb + (tid >> 4);
      const bool samp = r >= MP;
      const int sr = r - MP;
      const int pos = samp ? 2048 + (sr & 31) : (r & 4095);
      const f32x4 x = *(const f32x4*)((const float*)(ws + W_KIRAW) + (size_t)r * 64 + li * 4);
      float s = x[0] + x[1] + x[2] + x[3];
      s += __shfl_xor(s, 1); s += __shfl_xor(s, 2); s += __shfl_xor(s, 4); s += __shfl_xor(s, 8);
      const float mean = s * (1.f / 64.f);
      const f32x4 d = x - mean;
      float ss = d[0] * d[0] + d[1] * d[1] + d[2] * d[2] + d[3] * d[3];
      ss += __shfl_xor(ss, 1); ss += __shfl_xor(ss, 2); ss += __shfl_xor(ss, 4); ss += __shfl_xor(ss, 8);
      const float rstd = rsqrtf(ss * (1.f / 64.f) + LN_EPS);
      f32x4 y = d * rstd * gg + bb;
      f32x4 pr;
#pragma unroll
      for (int e = 0; e < 4; ++e) pr[e] = __shfl_xor(y[e], 2);
      if (li < 4) {
        const int i0 = (li & 1) * 4;
        const f32x4 t0 = *(const f32x4*)(rope + (size_t)pos * 16 + i0 * 2), t1 = *(const f32x4*)(rope + (size_t)pos * 16 + i0 * 2 + 4);
        const float cc[4] = {t0[0], t0[2], t1[0], t1[2]}, sn[4] = {t0[1], t0[3], t1[1], t1[3]};
#pragma unroll
        for (int e = 0; e < 4; ++e) y[e] = (li < 2) ? (y[e] * cc[e] - pr[e] * sn[e]) : (pr[e] * sn[e] + y[e] * cc[e]);
      }
      u32x2 wv;
      wv[0] = cvt_pk_bf16(y[0], y[1]); wv[1] = cvt_pk_bf16(y[2], y[3]);
      if (!samp) {
        *(f32x4*)(kp->out + O_PIK + ((size_t)l * MP + r) * 64 + li * 4) = y;
        *(u32x2*)((bf16_t*)(ws + W_KIP) + (size_t)(r >> 12) * 4096 * 64 + kif_off(r & 4095, li)) = wv;
      } else {
        *(f32x4*)(kp->out + O_SIK + ((size_t)l * MS + sr) * 64 + li * 4) = y;
        *(u32x2*)((bf16_t*)(ws + W_KIS) + (size_t)(l * 16 + (sr >> 5)) * 2080 * 64 + kif_off(2048 + (sr & 31), li)) = wv;
      }
    }
  }
  bf16_t* vnT = (bf16_t*)shm;
  const bf16_t* VG = (const bf16_t*)(ws + W_VG);
  bf16_t* U = (bf16_t*)(ws + W_U);
  const bf16_t* WSM = (const bf16_t*)(ws + W_WSM) + (size_t)l * 4 * 128 * 128;
  for (int tile = bid; tile < 272; tile += nb) {
    const bool samp = tile >= 256;
    const int rbase = samp ? MP + (tile - 256) * 32 : tile * 128;
    const int nrows = samp ? 32 : 128;
    {
      const int row = tid >> 2, qtr = tid & 3;
      if (row < nrows) {
        const bf16_t* src = VG + (size_t)(rbase + row) * 512 + qtr * 128;
        float s = 0.f, ss = 0.f;
#pragma unroll 4
        for (int e = 0; e < 16; ++e) {
          const u32x4 rw = *(const u32x4*)(src + e * 8);
#pragma unroll
          for (int q = 0; q < 4; ++q) { const float a = bflo(rw[q]), b = bfhi(rw[q]); s += a + b; ss += a * a + b * b; }
        }
        s += __shfl_xor(s, 1); s += __shfl_xor(s, 2);
        ss += __shfl_xor(ss, 1); ss += __shfl_xor(ss, 2);
        const float mean = s * (1.f / 512.f);
        const float var = fmaxf(ss * (1.f / 512.f) - mean * mean, 0.f);
        const float rstd = rsqrtf(var + LN_EPS);
        const float* gp = kp->sgu_g + l * 512 + qtr * 128;
        const float* bp = kp->sgu_b + l * 512 + qtr * 128;
        float* so = kp->out + O_SSV + ((size_t)l * MS + (rbase - MP) + row) * 512 + qtr * 128;
#pragma unroll 2
        for (int e = 0; e < 16; ++e) {
          const u32x4 rw = *(const u32x4*)(src + e * 8);
          const f32x4 g0 = *(const f32x4*)(gp + e * 8), g1 = *(const f32x4*)(gp + e * 8 + 4);
          const f32x4 b0 = *(const f32x4*)(bp + e * 8), b1 = *(const f32x4*)(bp + e * 8 + 4);
          float y[8];
#pragma unroll
          for (int q = 0; q < 4; ++q) {
            const float a = bflo(rw[q]), b = bfhi(rw[q]);
            const float ga = q < 2 ? g0[2 * q] : g1[2 * q - 4], gb = q < 2 ? g0[2 * q + 1] : g1[2 * q - 3];
            const float ba = q < 2 ? b0[2 * q] : b1[2 * q - 4], bb2 = q < 2 ? b0[2 * q + 1] : b1[2 * q - 3];
            y[2 * q] = (a - mean) * rstd * ga + ba;
            y[2 * q + 1] = (b - mean) * rstd * gb + bb2;
          }
          if (samp) {
            *(f32x4*)(so + e * 8) = (f32x4){y[0], y[1], y[2], y[3]};
            *(f32x4*)(so + e * 8 + 4) = (f32x4){y[4], y[5], y[6], y[7]};
          }
#pragma unroll
          for (int q = 0; q < 4; ++q) {
            const unsigned pk = cvt_pk_bf16(y[2 * q], y[2 * q + 1]);
            const int d = qtr * 128 + e * 8 + 2 * q;
            vnT[(size_t)d * 136 + row] = (bf16_t)(pk & 0xffffu);
            vnT[(size_t)(d + 1) * 136 + row] = (bf16_t)(pk >> 16);
          }
        }
      }
    }
    __syncthreads();
    if (!samp || w < 2) {
      const int tl = lane & 15, kg = lane >> 4;
      const int t = 16 * w + tl;
      const int r = rbase + t;
      for (int g = 0; g < 4; ++g) {
        f32x4 acc[8];
#pragma unroll
        for (int db = 0; db < 8; ++db) acc[db] = (f32x4){0.f, 0.f, 0.f, 0.f};
#pragma unroll
        for (int ks = 0; ks < 4; ++ks) {
          if (ks * 32 <= 16 * w + 15) {
            const bf16x8 wf = *(const bf16x8*)(WSM + ((size_t)g * 128 + t) * 128 + ks * 32 + kg * 8);
#pragma unroll
            for (int db = 0; db < 8; ++db) {
              const bf16x8 vf = *(const bf16x8*)(vnT + (size_t)(g * 128 + db * 16 + tl) * 136 + ks * 32 + kg * 8);
              acc[db] = __builtin_amdgcn_mfma_f32_16x16x32_bf16(vf, wf, acc[db], 0, 0, 0);
            }
          }
        }
        const float bias = kp->b_s[(l * 4 + g) * 128 + t];
#pragma unroll
        for (int db = 0; db < 8; ++db) {
          bf16_t* up = U + (size_t)r * 512 + g * 128 + db * 16 + kg * 4;
          const u32x2 uw = *(const u32x2*)up;
          u32x2 ow;
          ow[0] = cvt_pk_bf16(bflo(uw[0]) * (acc[db][0] + bias), bfhi(uw[0]) * (acc[db][1] + bias));
          ow[1] = cvt_pk_bf16(bflo(uw[1]) * (acc[db][2] + bias), bfhi(uw[1]) * (acc[db][3] + bias));
          *(u32x2*)up = ow;
        }
      }
    }
    __syncthreads();
  }
}

__device__ __forceinline__ int mbcnt64(unsigned long long m) { return __builtin_amdgcn_mbcnt_hi((unsigned)(m >> 32), __builtin_amdgcn_mbcnt_lo((unsigned)m, 0u)); }

template <int NB>
__device__ __forceinline__ void bisect256(const unsigned (&x)[64], unsigned& tau_out, int& cge_out) {
  unsigned tau = 0u;
  int cge = 0;
  for (int bit = 31; bit >= 0; --bit) {
    const unsigned cand = tau | (1u << bit);
    unsigned cl = 0u;
#pragma unroll
    for (int blk = 0; blk < NB; ++blk) {
      unsigned long long m0, m1, m2, m3, m4, m5, m6, m7;
      asm volatile(
          "v_cmp_ge_u32_e64 %1, %9, %17\n\tv_cmp_ge_u32_e64 %2, %10, %17\n\tv_cmp_ge_u32_e64 %3, %11, %17\n\tv_cmp_ge_u32_e64 %4, %12, %17\n\t"
          "v_cmp_ge_u32_e64 %5, %13, %17\n\tv_cmp_ge_u32_e64 %6, %14, %17\n\tv_cmp_ge_u32_e64 %7, %15, %17\n\tv_cmp_ge_u32_e64 %8, %16, %17\n\t"
          "v_addc_co_u32_e64 %0, %1, 0, %0, %1\n\tv_addc_co_u32_e64 %0, %2, 0, %0, %2\n\tv_addc_co_u32_e64 %0, %3, 0, %0, %3\n\t"
          "v_addc_co_u32_e64 %0, %4, 0, %0, %4\n\tv_addc_co_u32_e64 %0, %5, 0, %0, %5\n\tv_addc_co_u32_e64 %0, %6, 0, %0, %6\n\t"
          "v_addc_co_u32_e64 %0, %7, 0, %0, %7\n\tv_addc_co_u32_e64 %0, %8, 0, %0, %8"
          : "+v"(cl), "=&s"(m0), "=&s"(m1), "=&s"(m2), "=&s"(m3), "=&s"(m4), "=&s"(m5), "=&s"(m6), "=&s"(m7)
          : "v"(x[blk * 8 + 0]), "v"(x[blk * 8 + 1]), "v"(x[blk * 8 + 2]), "v"(x[blk * 8 + 3]), "v"(x[blk * 8 + 4]), "v"(x[blk * 8 + 5]),
            "v"(x[blk * 8 + 6]), "v"(x[blk * 8 + 7]), "v"(cand));
    }
    cl += (unsigned)__builtin_amdgcn_update_dpp(0, (int)cl, 0x111, 0xf, 0xf, true);
    cl += (unsigned)__builtin_amdgcn_update_dpp(0, (int)cl, 0x112, 0xf, 0xf, true);
    cl += (unsigned)__builtin_amdgcn_update_dpp(0, (int)cl, 0x114, 0xf, 0xf, true);
    cl += (unsigned)__builtin_amdgcn_update_dpp(0, (int)cl, 0x118, 0xf, 0xf, true);
    const int cnt = __builtin_amdgcn_readlane((int)cl, 15) + __builtin_amdgcn_readlane((int)cl, 31) + __builtin_amdgcn_readlane((int)cl, 47) +
                    __builtin_amdgcn_readlane((int)cl, 63);
    if (cnt >= 256) { tau = cand; cge = cnt; }
    if (cnt == 256) break;
  }
  tau_out = tau;
  cge_out = cge;
}

struct SelPre { bf16x8 af[4]; f32x4 wv[4]; bf16x8 b0[4][4]; };
__device__ __forceinline__ void sel_prefetch(SelPre& p, unsigned char* ws, int r0, const bf16_t* __restrict__ kib, int n, int w, int lane) {
  if (n <= 256) return;
  const int i = lane & 31, kg = lane >> 5;
  const bf16_t* qrow = (const bf16_t*)(ws + W_QI) + (size_t)(r0 + (i >> 2)) * 256 + (i & 3) * 64 + kg * 8;
#pragma unroll
  for (int ks = 0; ks < 4; ++ks) p.af[ks] = *(const bf16x8*)(qrow + ks * 16);
#pragma unroll
  for (int jj = 0; jj < 4; ++jj) p.wv[jj] = *(const f32x4*)((const float*)(ws + W_WI) + (size_t)(r0 + 2 * jj + kg) * 4);
}
__device__ __forceinline__ void sel_prefetch_keys(SelPre& p, const bf16_t* __restrict__ kib, int n, int w, int lane) {
  if (n <= 256) return;
  const int nkb = n >> 5;
#pragma unroll
  for (int u = 0; u < 4; ++u) {
    const int kbu = w + 8 * u < nkb ? w + 8 * u : w;
    const bf16_t* krow = kib + (size_t)kbu * 2048 + lane * 8;
#pragma unroll
    for (int ks = 0; ks < 4; ++ks) p.b0[u][ks] = *(const bf16x8*)(krow + ks * 512);
  }
}
__device__ __forceinline__ void select_group(unsigned char* ws, int r0, const bf16_t* __restrict__ kib, int n, float* sc, SelPre& pre, int nr0, const bf16_t* __restrict__ nkib, int nn) {
  const int tid = otid(), lane = tid & 63, w = tid >> 6;
  unsigned short* SEL = (unsigned short*)(ws + W_SEL);
  if (n <= 256) {
    unsigned short* selrow = SEL + (size_t)(r0 + w) * 256;
    for (int i = lane; i < n; i += 64) selrow[i] = (unsigned short)i;
    if (nn > 0) { sel_prefetch(pre, ws, nr0, nkib, nn, w, lane); sel_prefetch_keys(pre, nkib, nn, w, lane); }
    return;
  }
  {
    const int i = lane & 31, kg = lane >> 5;
    bf16x8 af[4];
    f32x4 wv[4];
#pragma unroll
    for (int ks = 0; ks < 4; ++ks) af[ks] = pre.af[ks];
#pragma unroll
    for (int jj = 0; jj < 4; ++jj) wv[jj] = pre.wv[jj];
    const int nkb = n >> 5;
    for (int kb0 = w; kb0 < nkb; kb0 += 32) {
      bf16x8 bfr[4][4];
      if (kb0 == w) {
#pragma unroll
        for (int u = 0; u < 4; ++u)
#pragma unroll
          for (int ks = 0; ks < 4; ++ks) bfr[u][ks] = pre.b0[u][ks];
      } else {
#pragma unroll
        for (int u = 0; u < 4; ++u) {
          const int kbu = kb0 + 8 * u < nkb ? kb0 + 8 * u : kb0;
          const bf16_t* krow = kib + (size_t)kbu * 2048 + lane * 8;
#pragma unroll
          for (int ks = 0; ks < 4; ++ks) bfr[u][ks] = *(const bf16x8*)(krow + ks * 512);
        }
      }
#pragma unroll
      for (int u = 0; u < 4; ++u) {
        if (kb0 + 8 * u < nkb) {
          const int key = (kb0 + 8 * u) * 32 + i;
          f32x16 acc;
#pragma unroll
          for (int e = 0; e < 16; ++e) acc[e] = 0.f;
#pragma unroll
          for (int ks = 0; ks < 4; ++ks) acc = __builtin_amdgcn_mfma_f32_32x32x16_bf16(af[ks], bfr[u][ks], acc, 0, 0, 0);
#pragma unroll
          for (int jj = 0; jj < 4; ++jj) {
            float sco = wv[jj][0] * fmaxf(acc[4 * jj], 0.f) + wv[jj][1] * fmaxf(acc[4 * jj + 1], 0.f) + wv[jj][2] * fmaxf(acc[4 * jj + 2], 0.f) +
                        wv[jj][3] * fmaxf(acc[4 * jj + 3], 0.f);
            sco += 0.0f;
            sc[(2 * jj + kg) * 4096 + key] = sco;
          }
        }
      }
    }
  }
  __syncthreads();
  if (nn > 0) sel_prefetch_keys(pre, nkib, nn, w, lane);
  {
    const float* rowl = sc + w * 4096 + lane;
    const int nreg = (n + 63) >> 6;
    const int nl = n - lane;
    unsigned x[64];
#pragma unroll
    for (int i = 0; i < 64; ++i) {
      const unsigned ub = __float_as_uint(rowl[i * 64]);
      const unsigned o = ub ^ ((unsigned)((int)ub >> 31) | 0x80000000u);
      x[i] = (i * 64 < nl) ? o : 0u;
    }
    unsigned tau = 0u;
    int cge = 0;
    switch ((nreg + 7) >> 3) {
      case 1: bisect256<1>(x, tau, cge); break;
      case 2: bisect256<2>(x, tau, cge); break;
      case 3: bisect256<3>(x, tau, cge); break;
      case 4: bisect256<4>(x, tau, cge); break;
      case 5: bisect256<5>(x, tau, cge); break;
      case 6: bisect256<6>(x, tau, cge); break;
      case 7: bisect256<7>(x, tau, cge); break;
      default: bisect256<8>(x, tau, cge); break;
    }
    unsigned tau2 = (unsigned)__builtin_amdgcn_readfirstlane((int)tau);
    asm volatile("" : "+s"(tau2));
    unsigned short* selrow = SEL + (size_t)(r0 + w) * 256;
    if (__builtin_amdgcn_readfirstlane(cge) == 256) {
      int myc = 0;
#pragma unroll
      for (int i = 0; i < 64; ++i) myc += (x[i] >= tau2) ? 1 : 0;
      int incl = myc;
#pragma unroll
      for (int d = 1; d < 64; d <<= 1) {
        const int t = __shfl_up(incl, d);
        incl += (lane >= d) ? t : 0;
      }
      int pos = incl - myc;
#pragma unroll
      for (int blk = 0; blk < 8; ++blk) {
        if (blk * 8 < nreg) {
#pragma unroll
          for (int i = blk * 8; i < blk * 8 + 8; ++i) {
            if (x[i] >= tau2) { selrow[pos] = (unsigned short)(i * 64 + lane); ++pos; }
          }
        }
      }
    } else {
      int cgt = 0;
#pragma unroll
      for (int blk = 0; blk < 8; ++blk) {
#pragma unroll
        for (int i = blk * 8; i < blk * 8 + 8; ++i) cgt += __popcll(__ballot(x[i] > tau2));
        __builtin_amdgcn_sched_barrier(0);
      }
      const int rem = 256 - cgt;
      int base = 0, taken = 0;
      unsigned tau3 = tau2;
      asm volatile("" : "+s"(tau3));
#pragma unroll
      for (int blk = 0; blk < 8; ++blk) {
        if (blk * 8 < nreg) {
#pragma unroll
          for (int i = blk * 8; i < blk * 8 + 8; ++i) {
            const bool gt = x[i] > tau3, eq = x[i] == tau3;
            const unsigned long long meq = __ballot(eq);
            const bool take = gt || (eq && (taken + mbcnt64(meq) < rem));
            const unsigned long long msel = __ballot(take);
            const int ps = base + mbcnt64(msel);
            if (take && ps < 256) selrow[ps] = (unsigned short)(i * 64 + lane);
            base += __popcll(msel);
            taken += __popcll(meq);
            __builtin_amdgcn_sched_barrier(0);
          }
        }
      }
    }
  }
  if (nn > 0) sel_prefetch(pre, ws, nr0, nkib, nn, w, lane);
  __syncthreads();
}

__device__ __forceinline__ void sel_params(unsigned char* ws, int l, int tile, int it, int& r0, const bf16_t*& kib, int& n) {
  if (tile < 256) {
    const int b = tile >> 5, cp = tile & 31, c = (it & 8) ? 63 - cp : cp;
    kib = (const bf16_t*)(ws + W_KIP) + (size_t)b * 4096 * 64;
    r0 = b * 4096 + c * 64 + (it & 7) * 8;
    n = 64 * (c + 1);
  } else {
    const int sb = tile - 256;
    kib = (const bf16_t*)(ws + W_KIS) + (size_t)(l * 16 + sb) * 2080 * 64;
    r0 = MP + sb * 32 + it * 8;
    n = 2080;
  }
}
__device__ __forceinline__ void phase_select(KP kp, int l, unsigned char* shm) {
  kp = launder(kp);
  float* sc = (float*)shm;
  unsigned char* ws = kp->ws;
  const int tid = otid(), lane = tid & 63, w = tid >> 6;
  for (int tile0 = blockIdx.x; tile0 < 272; tile0 += gridDim.x) {
    const int tile = tile0 < 256 ? (tile0 & 7) * 32 + (tile0 >> 3) : tile0;
    const int ng = tile >= 256 ? 4 : 16;
    SelPre pre;
    {
      int r0, n; const bf16_t* kib;
      sel_params(ws, l, tile, 0, r0, kib, n);
      sel_prefetch(pre, ws, r0, kib, n, w, lane);
      sel_prefetch_keys(pre, kib, n, w, lane);
    }
    for (int it = 0; it < ng; ++it) {
      int r0, n, nr0 = 0, nn = 0;
      const bf16_t *kib, *nkib = nullptr;
      sel_params(ws, l, tile, it, r0, kib, n);
      if (it + 1 < ng) sel_params(ws, l, tile, it + 1, nr0, nkib, nn);
      select_group(ws, r0, kib, n, sc, pre, nr0, nkib, nn);
    }
  }
}

__device__ __forceinline__ void phase_attn(KP kp, int l, unsigned char* shm) {
  kp = launder(kp);
  const int tid = otid(), lane = tid & 63, w = __builtin_amdgcn_readfirstlane(tid >> 6);
  unsigned char* ws = kp->ws;
  unsigned char* tileb = shm + w * 5120;
  unsigned short* selw = (unsigned short*)(shm + w * 5120 + 4608);
  const unsigned tr_addr = (unsigned)(size_t)tileb + (unsigned)((4 * (lane >> 4) + ((lane & 15) >> 2)) * 144 + (lane & 3) * 8);
  bf16_t* Q = (bf16_t*)(ws + W_Q);
  const unsigned short* SEL = (const unsigned short*)(ws + W_SEL);
  const int nn = lane & 15, kg = lane >> 4;
  const int ks8 = lane >> 3, dc = lane & 7;
  for (int q = blockIdx.x * 8 + w; q < MT; q += gridDim.x * 8) {
    int r = q;
    if (gridDim.x == 256 && q < MP) r = ((q >> 3) & 7) * 4096 + (q >> 11) * 256 + ((q >> 6) & 31) * 8 + (q & 7);
    const bf16_t *kbase, *vbase;
    int n;
    if (r < MP) {
      const int b = r >> 12, t = r & 4095;
      kbase = (const bf16_t*)(ws + W_KP) + (size_t)b * 4096 * 128;
      vbase = (const bf16_t*)(ws + W_VP) + (size_t)b * 4096 * 128;
      n = ((t >> 6) + 1) * 64;
    } else {
      const int sb = (r - MP) >> 5;
      kbase = (const bf16_t*)(ws + W_KS) + (size_t)(l * 16 + sb) * 2080 * 128;
      vbase = (const bf16_t*)(ws + W_VS) + (size_t)(l * 16 + sb) * 2080 * 128;
      n = 2080;
    }
    const int cnt = n < 256 ? n : 256;
    {
      u32x2 sv = *(const u32x2*)(SEL + (size_t)r * 256 + lane * 4);
      const int k0 = lane * 4;
      unsigned a0 = sv[0] & 0xffffu, a1 = sv[0] >> 16, a2 = sv[1] & 0xffffu, a3 = sv[1] >> 16;
      a0 = (k0 < cnt) ? a0 : 0u; a1 = (k0 + 1 < cnt) ? a1 : 0u; a2 = (k0 + 2 < cnt) ? a2 : 0u; a3 = (k0 + 3 < cnt) ? a3 : 0u;
      u32x2 o;
      o[0] = a0 | (a1 << 16); o[1] = a2 | (a3 << 16);
      *(u32x2*)(selw + lane * 4) = o;
    }
    __builtin_amdgcn_wave_barrier();
    bf16x8 kpre[8][2];
#pragma unroll
    for (int kvh = 0; kvh < 2; ++kvh) {
      bf16x8 bq0, bq1;
#pragma unroll
      for (int e = 0; e < 8; ++e) { bq0[e] = 0; bq1[e] = 0; }
      if (nn < 4) {
        const bf16_t* qp = Q + (size_t)r * 512 + (kvh * 4 + nn) * 64 + kg * 8;
        bq0 = *(const bf16x8*)qp;
        bq1 = *(const bf16x8*)(qp + 32);
      }
      f32x4 lg[16];
      for (int repQ = 0; repQ < ((PROBE & 128) ? 2 : 1); ++repQ)
      {
#pragma unroll
        for (int hb = 0; hb < 2; ++hb) {
          bf16x8 ka[8][2];
          if (kvh == 1 && hb == 0) {
#pragma unroll
            for (int k8 = 0; k8 < 8; ++k8) { ka[k8][0] = kpre[k8][0]; ka[k8][1] = kpre[k8][1]; }
          } else {
#pragma unroll
            for (int k8 = 0; k8 < 8; ++k8) {
              const int idx = selw[(hb * 8 + k8) * 16 + nn];
              const bf16_t* kp = kbase + (size_t)idx * 128 + kvh * 64 + kg * 8;
              ka[k8][0] = *(const bf16x8*)kp;
              ka[k8][1] = *(const bf16x8*)(kp + 32);
            }
          }
          __builtin_amdgcn_sched_barrier(0);
#pragma unroll
          for (int k8 = 0; k8 < 8; ++k8) {
            f32x4 a = (f32x4){0.f, 0.f, 0.f, 0.f};
            a = __builtin_amdgcn_mfma_f32_16x16x32_bf16(ka[k8][0], bq0, a, 0, 0, 0);
            a = __builtin_amdgcn_mfma_f32_16x16x32_bf16(ka[k8][1], bq1, a, 0, 0, 0);
            lg[hb * 8 + k8] = a;
          }
          __builtin_amdgcn_sched_barrier(0);
        }
      }
      u32x4 vr[32];
#pragma unroll
      for (int i = 0; i < 16; ++i) {
        const int idx = selw[i * 8 + ks8];
        vr[i] = *(const u32x4*)(vbase + (size_t)idx * 128 + kvh * 64 + dc * 8);
      }
      float mx = -1e30f;
#pragma unroll
      for (int kb = 0; kb < 16; ++kb)
#pragma unroll
        for (int j = 0; j < 4; ++j) {
          const int key = kb * 16 + kg * 4 + j;
          lg[kb][j] = key < cnt ? lg[kb][j] : -1e30f;
          mx = fmaxf(mx, lg[kb][j]);
        }
      mx = fmaxf(mx, __shfl_xor(mx, 16));
      mx = fmaxf(mx, __shfl_xor(mx, 32));
      float sum = 0.f;
#pragma unroll
      for (int kb = 0; kb < 16; ++kb)
#pragma unroll
        for (int j = 0; j < 4; ++j) { lg[kb][j] = __expf(lg[kb][j] - mx); sum += lg[kb][j]; }
      sum += __shfl_xor(sum, 16);
      sum += __shfl_xor(sum, 32);
      const float inv = 1.f / sum;
      bf16x8 pf[8];
#pragma unroll
      for (int s8 = 0; s8 < 8; ++s8) {
        u32x4 pk;
        pk[0] = cvt_pk_bf16(lg[2 * s8][0], lg[2 * s8][1]);
        pk[1] = cvt_pk_bf16(lg[2 * s8][2], lg[2 * s8][3]);
        pk[2] = cvt_pk_bf16(lg[2 * s8 + 1][0], lg[2 * s8 + 1][1]);
        pk[3] = cvt_pk_bf16(lg[2 * s8 + 1][2], lg[2 * s8 + 1][3]);
        pf[s8] = __builtin_bit_cast(bf16x8, pk);
      }
      f32x4 oacc[4];
#pragma unroll
      for (int c = 0; c < 4; ++c) oacc[c] = (f32x4){0.f, 0.f, 0.f, 0.f};
      for (int repV = 0; repV < ((PROBE & 256) ? 2 : 1); ++repV)
      {
        if (repV) {
#pragma unroll
          for (int c = 0; c < 4; ++c) oacc[c] = (f32x4){0.f, 0.f, 0.f, 0.f};
        }
#pragma unroll
        for (int i = 16; i < 32; ++i) {
          const int idx = selw[i * 8 + ks8];
          vr[i] = *(const u32x4*)(vbase + (size_t)idx * 128 + kvh * 64 + dc * 8);
        }
#pragma unroll
        for (int s8 = 0; s8 < 8; ++s8) {
#pragma unroll
          for (int it = 0; it < 4; ++it) *(u32x4*)(tileb + (it * 8 + ks8) * 144 + dc * 16) = vr[s8 * 4 + it];
          u32x2 t0, t1, t2, t3, t4, t5, t6, t7;
          asm volatile(
              "ds_read_b64_tr_b16 %0, %8\n\tds_read_b64_tr_b16 %1, %8 offset:2304\n\t"
              "ds_read_b64_tr_b16 %2, %8 offset:32\n\tds_read_b64_tr_b16 %3, %8 offset:2336\n\t"
              "ds_read_b64_tr_b16 %4, %8 offset:64\n\tds_read_b64_tr_b16 %5, %8 offset:2368\n\t"
              "ds_read_b64_tr_b16 %6, %8 offset:96\n\tds_read_b64_tr_b16 %7, %8 offset:2400\n\t"
              "s_waitcnt lgkmcnt(0)"
              : "=&v"(t0), "=&v"(t1), "=&v"(t2), "=&v"(t3), "=&v"(t4), "=&v"(t5), "=&v"(t6), "=&v"(t7)
              : "v"(tr_addr)
              : "memory");
          const bf16x8 a0 = __builtin_bit_cast(bf16x8, (u32x4){t0[0], t0[1], t1[0], t1[1]});
          const bf16x8 a1 = __builtin_bit_cast(bf16x8, (u32x4){t2[0], t2[1], t3[0], t3[1]});
          const bf16x8 a2 = __builtin_bit_cast(bf16x8, (u32x4){t4[0], t4[1], t5[0], t5[1]});
          const bf16x8 a3 = __builtin_bit_cast(bf16x8, (u32x4){t6[0], t6[1], t7[0], t7[1]});
          oacc[0] = __builtin_amdgcn_mfma_f32_16x16x32_bf16(a0, pf[s8], oacc[0], 0, 0, 0);
          oacc[1] = __builtin_amdgcn_mfma_f32_16x16x32_bf16(a1, pf[s8], oacc[1], 0, 0, 0);
          oacc[2] = __builtin_amdgcn_mfma_f32_16x16x32_bf16(a2, pf[s8], oacc[2], 0, 0, 0);
          oacc[3] = __builtin_amdgcn_mfma_f32_16x16x32_bf16(a3, pf[s8], oacc[3], 0, 0, 0);
          if (kvh == 0 && s8 == 3) {
#pragma unroll
            for (int k8 = 0; k8 < 8; ++k8) {
              const int idx = selw[k8 * 16 + nn];
              const bf16_t* kp = kbase + (size_t)idx * 128 + 64 + kg * 8;
              kpre[k8][0] = *(const bf16x8*)kp;
              kpre[k8][1] = *(const bf16x8*)(kp + 32);
            }
          }
        }
        __builtin_amdgcn_sched_barrier(0);
      }
      if (nn < 4) {
#pragma unroll
        for (int c = 0; c < 4; ++c) {
          u32x2 ow;
          ow[0] = cvt_pk_bf16(oacc[c][0] * inv, oacc[c][1] * inv);
          ow[1] = cvt_pk_bf16(oacc[c][2] * inv, oacc[c][3] * inv);
          *(u32x2*)((bf16_t*)(ws + W_OA) + (size_t)r * 512 + (kvh * 4 + nn) * 64 + 16 * c + 4 * kg) = ow;
        }
      }
      __builtin_amdgcn_wave_barrier();
    }
  }
}

__device__ __forceinline__ void phase_ln(float* R, const float* __restrict__ g, const float* __restrict__ b, bf16_t* xbf, float samp_scale, const float* __restrict__ part, int nsplit, bool f32_all) {
  const int tid = otid(), lane = tid & 63, gw = blockIdx.x * 8 + (tid >> 6), nw = gridDim.x * 8;
  f32x4 gv[4], bv[4];
#pragma unroll
  for (int i = 0; i < 4; ++i) { gv[i] = *(const f32x4*)(g + i * 256 + lane * 4); bv[i] = *(const f32x4*)(b + i * 256 + lane * 4); }
  for (int r = gw; r < MT; r += nw) {
    float* row = R + (size_t)r * 1024;
    f32x4 v[4];
#pragma unroll
    for (int i = 0; i < 4; ++i) v[i] = *(const f32x4*)(row + i * 256 + lane * 4);
    if (r >= MP) {
      for (int sp = 0; sp < nsplit; ++sp) {
        const float* prow = part + ((size_t)sp * MS + (r - MP)) * 1024;
#pragma unroll
        for (int i = 0; i < 4; ++i) v[i] = v[i] + *(const f32x4*)(prow + i * 256 + lane * 4);
      }
    }
    float s = 0.f;
#pragma unroll
    for (int i = 0; i < 4; ++i) s += v[i][0] + v[i][1] + v[i][2] + v[i][3];
#pragma unroll
    for (int o = 32; o >= 1; o >>= 1) s += __shfl_xor(s, o);
    const float mean = s * (1.f / 1024.f);
    float ss = 0.f;
#pragma unroll
    for (int i = 0; i < 4; ++i) { v[i] = v[i] - mean; ss += v[i][0] * v[i][0] + v[i][1] * v[i][1] + v[i][2] * v[i][2] + v[i][3] * v[i][3]; }
#pragma unroll
    for (int o = 32; o >= 1; o >>= 1) ss += __shfl_xor(ss, o);
    const float rstd = rsqrtf(ss * (1.f / 1024.f) + LN_EPS);
#pragma unroll
    for (int i = 0; i < 4; ++i) {
      const f32x4 y = v[i] * rstd * gv[i] + bv[i];
      if (r >= MP) *(f32x4*)(row + i * 256 + lane * 4) = y * samp_scale;
      else if (f32_all) *(f32x4*)(row + i * 256 + lane * 4) = y;
      if (xbf) {
        u32x2 wv;
        wv[0] = cvt_pk_bf16(y[0], y[1]); wv[1] = cvt_pk_bf16(y[2], y[3]);
        *(u32x2*)(xbf + (size_t)r * 1024 + i * 256 + lane * 4) = wv;
      }
    }
  }
}

__device__ __forceinline__ void tile32(const bf16_t* __restrict__ A, int lda, const bf16_t* __restrict__ Bt, int ldb, int K, int row0, int col0, int lane, f32x4 (&c)[2][2]) {
  const int i = lane & 15, kg = lane >> 4;
  const bf16_t* a0 = A + (size_t)(row0 + i) * lda + kg * 8;
  const bf16_t* a1 = a0 + (size_t)16 * lda;
  const bf16_t* b0 = Bt + (size_t)(col0 + i) * ldb + kg * 8;
  const bf16_t* b1 = b0 + (size_t)16 * ldb;
#pragma unroll 4
  for (int k = 0; k < K; k += 32) {
    const bf16x8 af0 = *(const bf16x8*)(a0 + k), af1 = *(const bf16x8*)(a1 + k), bf0 = *(const bf16x8*)(b0 + k), bf1 = *(const bf16x8*)(b1 + k);
    c[0][0] = __builtin_amdgcn_mfma_f32_16x16x32_bf16(af0, bf0, c[0][0], 0, 0, 0);
    c[0][1] = __builtin_amdgcn_mfma_f32_16x16x32_bf16(af0, bf1, c[0][1], 0, 0, 0);
    c[1][0] = __builtin_amdgcn_mfma_f32_16x16x32_bf16(af1, bf0, c[1][0], 0, 0, 0);
    c[1][1] = __builtin_amdgcn_mfma_f32_16x16x32_bf16(af1, bf1, c[1][1], 0, 0, 0);
  }
}
__device__ __forceinline__ void sample_proj(unsigned char* ws, int l) {
  const int tid = otid(), lane = tid & 63, gw = blockIdx.x * 8 + (tid >> 6), nw = gridDim.x * 8;
  const bf16_t* GA = (const bf16_t*)(ws + W_GA);
  const bf16_t* GB = (const bf16_t*)(ws + W_GB);
  bf16_t* MRG = (bf16_t*)(ws + W_MRG);
  for (int t = gw; t < 16 * 32; t += nw) {
    const int row0 = MP + (t >> 5) * 32, col0 = (t & 31) * 32;
    f32x4 ca[2][2], cb[2][2];
#pragma unroll
    for (int x = 0; x < 2; ++x)
#pragma unroll
      for (int y = 0; y < 2; ++y) { ca[x][y] = (f32x4){0.f, 0.f, 0.f, 0.f}; cb[x][y] = (f32x4){0.f, 0.f, 0.f, 0.f}; }
    tile32((const bf16_t*)(ws + W_OA), 512, (const bf16_t*)(ws + W_WPA) + (size_t)l * 1024 * 512, 512, 512, row0, col0, lane, ca);
    tile32((const bf16_t*)(ws + W_U), 512, (const bf16_t*)(ws + W_WPB) + (size_t)l * 1024 * 512, 512, 512, row0, col0, lane, cb);
#pragma unroll
    for (int rb = 0; rb < 2; ++rb)
#pragma unroll
      for (int cc = 0; cc < 2; ++cc)
#pragma unroll
        for (int j = 0; j < 4; ++j) {
          const size_t o = (size_t)(row0 + 16 * rb + (lane >> 4) * 4 + j) * 1024 + col0 + 16 * cc + (lane & 15);
          const float m = ((float)((const unsigned char*)GA)[o] * ca[rb][cc][j] + (float)((const unsigned char*)GB)[o] * cb[rb][cc][j]) * (1.f / 255.f);
          MRG[o] = (bf16_t)(cvt_pk_bf16(m, 0.f) & 0xffffu);
        }
  }
}
__device__ __forceinline__ void sample_ff1(unsigned char* ws, int l) {
  const int tid = otid(), lane = tid & 63, gw = blockIdx.x * 8 + (tid >> 6), nw = gridDim.x * 8;
  bf16_t* H = (bf16_t*)(ws + W_H);
  for (int t = gw; t < 16 * 128; t += nw) {
    const int row0 = MP + (t >> 7) * 32, col0 = (t & 127) * 32;
    f32x4 c[2][2];
#pragma unroll
    for (int x = 0; x < 2; ++x)
#pragma unroll
      for (int y = 0; y < 2; ++y) c[x][y] = (f32x4){0.f, 0.f, 0.f, 0.f};
    tile32((const bf16_t*)(ws + W_XBF), 1024, (const bf16_t*)(ws + W_FF1) + (size_t)l * 4096 * 1024, 1024, 1024, row0, col0, lane, c);
#pragma unroll
    for (int rb = 0; rb < 2; ++rb)
#pragma unroll
      for (int cc = 0; cc < 2; ++cc)
#pragma unroll
        for (int j = 0; j < 4; ++j) {
          const float a = fmaxf(c[rb][cc][j], 0.f);
          H[(size_t)(row0 + 16 * rb + (lane >> 4) * 4 + j) * LDH + col0 + 16 * cc + (lane & 15)] = (bf16_t)(cvt_pk_bf16(a * a, 0.f) & 0xffffu);
        }
  }
}

#define XB_TMO      128
#define XB_XCNT(j)  (256  + 64 * (j))
#define XB_XSUB(j)  (1280 + 64 * (j))
#define XB_XGEN(j)  (2304 + 64 * (j))
#define XB_TOP      3328
#define XB_TOPGEN   3392
#define XCD_BAR_WORDS 3456
#define XB_SPIN_CAP (1u << 18)
__device__ __forceinline__ unsigned xb_ld(unsigned* p) { return __hip_atomic_load(p, __ATOMIC_RELAXED, __HIP_MEMORY_SCOPE_AGENT); }
__device__ __forceinline__ unsigned xb_add(unsigned* p, unsigned v) { return __hip_atomic_fetch_add(p, v, __ATOMIC_RELAXED, __HIP_MEMORY_SCOPE_AGENT); }
__device__ __forceinline__ unsigned xb_xcc_id() { return (unsigned)__builtin_amdgcn_s_getreg((3 << 11) | 20) & 0xFu; }
#define XB_SPIN(cond, bar) do { unsigned _sp = 0; while (cond) { __builtin_amdgcn_s_sleep(1); \
    if ((++_sp & 255u) == 0u) { if (xb_ld(&(bar)[XB_TMO])) break; if (_sp > XB_SPIN_CAP) { atomicAdd(&(bar)[XB_TMO], 1u); break; } } } } while (0)
__device__ __forceinline__ void xcd_barrier_complete(unsigned* bar, unsigned x, unsigned& nloc, unsigned& nx) {
  const unsigned G = gridDim.x * gridDim.y * gridDim.z;
  unsigned sum, cnt, mine, sp = 0u;
  for (;;) {
    sum = 0u; cnt = 0u; mine = 0u;
#pragma unroll
    for (unsigned j = 0; j < 16; ++j) { const unsigned c = xb_ld(&bar[XB_XCNT(j)]); sum += c; cnt += (c > 0u) ? 1u : 0u; mine = (j == x) ? c : mine; }
    if (sum == G) break;
    __builtin_amdgcn_s_sleep(1);
    if ((++sp & 255u) == 0u) { if (xb_ld(&bar[XB_TMO])) break; if (sp > XB_SPIN_CAP) { atomicAdd(&bar[XB_TMO], 1u); break; } }
  }
  nloc = mine > 0u ? mine : 1u; nx = cnt > 0u ? cnt : 1u;
}
__device__ __forceinline__ void xcd_barrier(KP kp, volatile LAS unsigned* st) {
  asm volatile("s_waitcnt vmcnt(0)" ::: "memory");
  __syncthreads();
  if (threadIdx.x == 0) {
    unsigned* bar = (unsigned*)(launder(kp)->ws + W_BAR);
    const unsigned x = xb_xcc_id();
    __builtin_amdgcn_s_waitcnt(0);
    unsigned nloc = st[0], nx = st[1];
    if (nloc == 0u) { xcd_barrier_complete(bar, x, nloc, nx); st[0] = nloc; st[1] = nx; }
    const unsigned old = xb_add(&bar[XB_XSUB(x)], 1u);
    const unsigned gen = old / nloc;
    if (old + 1u == (gen + 1u) * nloc) {
      __builtin_amdgcn_fence(__ATOMIC_RELEASE, "agent");
      asm volatile("s_waitcnt vmcnt(0)" ::: "memory");
      const unsigned og = xb_add(&bar[XB_TOP], 1u);
      const unsigned tg = og / nx;
      if (og + 1u == (tg + 1u) * nx) xb_add(&bar[XB_TOPGEN], 1u);
      else XB_SPIN(xb_ld(&bar[XB_TOPGEN]) == tg, bar);
      __builtin_amdgcn_fence(__ATOMIC_ACQUIRE, "agent");
      xb_add(&bar[XB_XGEN(x)], 1u);
      asm volatile("s_waitcnt vmcnt(0)" ::: "memory");
    } else {
      XB_SPIN(xb_ld(&bar[XB_XGEN(x)]) == gen, bar);
      __builtin_amdgcn_fence(__ATOMIC_ACQUIRE, "agent");
      asm volatile("s_waitcnt vmcnt(0)" ::: "memory");
    }
  }
  __syncthreads();
}

#ifndef PH_MASK
#define PH_MASK 0xFFFF
#endif
__global__ void __launch_bounds__(512, 2) mega(Params p_unused) {
  extern __shared__ __attribute__((aligned(16))) unsigned char shm[];
  cg::grid_group grid = cg::this_grid();
  LAS unsigned char* lds = (LAS unsigned char*)shm;
  const KP kp0 = (KP)__builtin_amdgcn_kernarg_segment_ptr();
  volatile LAS unsigned* st = (volatile LAS unsigned*)(lds + 139264);
  if (threadIdx.x < 2) st[threadIdx.x] = 0u;
  __syncthreads();
  if (threadIdx.x == 0) (void)xb_add(&((unsigned*)(kp0->ws + W_BAR))[XB_XCNT(xb_xcc_id())], 1u);

  for (int rep = 0; rep < ((PROBE & 4) ? 2 : 1); ++rep)
  if (PH_MASK & 1) phase_prep(kp0, shm);
  if (kp0->ws == nullptr) grid.sync();
  xcd_barrier(kp0, st);
#pragma unroll 1
  for (int l = 0; l < 2; ++l) {
    for (int rep = 0; rep < ((PROBE & 1) ? 2 : 1); ++rep)
    if (PH_MASK & 2) {
      const KP kp = launder(kp0);
      unsigned char* ws = kp->ws;
      pg8::Gemm g{(bf16_t*)(ws + W_XBF), (const bf16_t*)(ws + W_WIN) + (size_t)l * NPK * 1024, MT, NPK, 1024, 1024, 1024, nullptr, nullptr};
      pg8::StaticOrder S;
      S.init(g.N, g.K, 1, gridDim.x, blockIdx.x);
      EpiIn E{l, kp->out, ws};
      pg8::gemm_phase(lds, g, S, E);
    }
    xcd_barrier(kp0, st);
    if (PH_MASK & 4) phase_fix(kp0, l, shm);
    xcd_barrier(kp0, st);
    for (int rep = 0; rep < ((PROBE & 2) ? 2 : 1); ++rep)
    if (PH_MASK & 8) phase_select(kp0, l, shm);
    xcd_barrier(kp0, st);
    for (int rep = 0; rep < ((PROBE & 32) ? 2 : 1); ++rep)
    if (PH_MASK & 16) phase_attn(kp0, l, shm);
    xcd_barrier(kp0, st);
    for (int rep = 0; rep < ((PROBE & 1024) ? 2 : 1); ++rep)
    if (PH_MASK & 32) {
      const KP kp = launder(kp0);
      unsigned char* ws = kp->ws;
      sample_proj(ws, l);
      pg8::StaticOrder S;
      S.init(1024, 512, 0, gridDim.x, blockIdx.x);
      {
        pg8::Gemm g{(const bf16_t*)(ws + W_OA), (const bf16_t*)(ws + W_WPA) + (size_t)l * 1024 * 512, MT, 1024, 512, 512, 512,
                    (const bf16_t*)(ws + W_U), (const bf16_t*)(ws + W_WPB) + (size_t)l * 1024 * 512};
        S.dual = 1;
        EpiGate E{(const unsigned char*)(ws + W_GA), (const unsigned char*)(ws + W_GB), (bf16_t*)(ws + W_MRG)};
        pg8::gemm_phase(lds, g, S, E);
      }
    }
    xcd_barrier(kp0, st);
    for (int rep = 0; rep < ((PROBE & 2048) ? 2 : 1); ++rep)
    if (PH_MASK & 64) {
      const KP kp = launder(kp0);
      unsigned char* ws = kp->ws;
      float* R = kp->out + O_Y;
      pg8::Gemm g{(bf16_t*)(ws + W_MRG), (const bf16_t*)(ws + W_WOUT) + (size_t)l * 1024 * 1024, MT, 1024, 1024, 1024, 1024, nullptr, nullptr};
      pg8::StaticOrder S;
      S.init(g.N, g.K, 4, gridDim.x, blockIdx.x);
      EpiRes E{l == 0 ? kp->x_prompt : nullptr, (const bf16_t*)(ws + W_XBF), R, (float*)(ws + W_PART)};
      pg8::gemm_phase(lds, g, S, E);
    }
    xcd_barrier(kp0, st);
    if (PH_MASK & 128) {
      const KP kp = launder(kp0);
      phase_ln(kp->out + O_Y, kp->ln1_g + l * 1024, kp->ln1_b + l * 1024, (bf16_t*)(kp->ws + W_XBF), ALPHA, (const float*)(kp->ws + W_PART), 4, false);
    }
    xcd_barrier(kp0, st);
    for (int rep = 0; rep < ((PROBE & 512) ? 2 : 1); ++rep)
    if (PH_MASK & 256) {
      const KP kp = launder(kp0);
      unsigned char* ws = kp->ws;
      sample_ff1(ws, l);
      pg8::Gemm g{(bf16_t*)(ws + W_XBF), (const bf16_t*)(ws + W_FF1) + (size_t)l * 4096 * 1024, MT, DFF, 1024, 1024, 1024, nullptr, nullptr};
      pg8::StaticOrder S;
      S.init(g.N, g.K, 0, gridDim.x, blockIdx.x);
      EpiFF1 E{(bf16_t*)(ws + W_H)};
      pg8::gemm_phase(lds, g, S, E);
    }
    xcd_barrier(kp0, st);
    for (int rep = 0; rep < ((PROBE & 4096) ? 2 : 1); ++rep)
    if (PH_MASK & 512) {
      const KP kp = launder(kp0);
      unsigned char* ws = kp->ws;
      float* R = kp->out + O_Y;
      pg8::Gemm g{(const bf16_t*)(ws + W_H), (const bf16_t*)(ws + W_FF2) + (size_t)l * 1024 * LDH, MT, 1024, 4096, LDH, LDH, nullptr, nullptr};
      pg8::StaticOrder S;
      S.init(g.N, g.K, 8, gridDim.x, blockIdx.x);
      EpiRes E{nullptr, (const bf16_t*)(ws + W_XBF), R, (float*)(ws + W_PART)};
      pg8::gemm_phase(lds, g, S, E);
    }
    xcd_barrier(kp0, st);
    if (PH_MASK & 1024) {
      const KP kp = launder(kp0);
      phase_ln(kp->out + O_Y, kp->ln2_g + l * 1024, kp->ln2_b + l * 1024, l == 0 ? (bf16_t*)(kp->ws + W_XBF) : nullptr, l == 0 ? ALPHA : 1.0f, (const float*)(kp->ws + W_PART), 8, l == 1);
    }
    xcd_barrier(kp0, st);
  }
  if (PROBE & 64) { for (int q = 0; q < 40; ++q) xcd_barrier(kp0, st); }
}

extern "C" void kernel_launch(void* const* d_in, const int* in_sizes, int n_in, void* d_out, int out_size, void* d_ws, size_t ws_size,
                              hipStream_t stream) {
  static int grid_blocks = 0;
  if (!grid_blocks) {
    int dev = 0, cus = 0, per_cu = 0;
    if (n_in != 21 || (size_t)out_size != O_END || ws_size < W_END) {
      fprintf(stderr, "kernel_launch: unexpected sizes n_in %d out %d ws %zu (need %zu)\n", n_in, out_size, ws_size, (size_t)W_END);
      grid_blocks = -1;
      return;
    }
    if (hipGetDevice(&dev) != hipSuccess || hipDeviceGetAttribute(&cus, hipDeviceAttributeMultiprocessorCount, dev) != hipSuccess) { grid_blocks = -1; return; }
    if (hipFuncSetAttribute((const void*)mega, hipFuncAttributeMaxDynamicSharedMemorySize, LDS_BYTES) != hipSuccess) { grid_blocks = -1; return; }
    if (hipOccupancyMaxActiveBlocksPerMultiprocessor(&per_cu, (const void*)mega, 512, LDS_BYTES) != hipSuccess || per_cu < 1) {
      fprintf(stderr, "kernel_launch: occupancy query says %d blocks/CU\n", per_cu);
      grid_blocks = -1;
      return;
    }
    grid_blocks = cus;
  }
  if (grid_blocks < 0) return;
  Params p{};
  const float** pp = (const float**)&p;
  for (int i = 0; i < 21; ++i) pp[i] = (const float*)d_in[i];
  p.out = (float*)d_out;
  p.ws = (unsigned char*)d_ws;
  if (hipMemsetAsync((unsigned char*)d_ws + W_BAR, 0, 16384, stream) != hipSuccess) { fprintf(stderr, "kernel_launch: memset of barrier words failed\n"); return; }
  void* args[] = {&p};
  hipError_t e = hipLaunchCooperativeKernel((void*)mega, dim3(grid_blocks), dim3(512), args, LDS_BYTES, stream);
  if (e != hipSuccess) fprintf(stderr, "cooperative launch failed: %s (grid %d)\n", hipGetErrorString(e), grid_blocks);
}
```

```cpp
#include <hip/hip_runtime.h>
#include <hip/hip_cooperative_groups.h>
#include <cstdio>
namespace cg = cooperative_groups;

#ifndef PROBE
#define PROBE 0
#endif
#define LAS __attribute__((address_space(3)))
typedef unsigned short bf16_t;
typedef short bf16x8 __attribute__((ext_vector_type(8)));
typedef float f32x4 __attribute__((ext_vector_type(4)));
typedef float f32x16 __attribute__((ext_vector_type(16)));
typedef unsigned u32x4 __attribute__((ext_vector_type(4)));
typedef unsigned u32x2 __attribute__((ext_vector_type(2)));

constexpr int MP = 32768, MS = 512, MT = 33280, DM = 1024, NPK = 4352, DFF = 4096;
constexpr int LDH = 4096 + 64;
constexpr float ALPHA = 1.41421356237f, LN_EPS = 1e-5f;
constexpr size_t O_Y = 0, O_PK = 34078720, O_PV = 42467328, O_PIK = 50855936, O_SK = 55050240, O_SV = 55181312, O_SIK = 55312384,
                 O_SSV = 55377920, O_END = 55902208;
constexpr size_t W_WIN = 0;
constexpr size_t W_WPA = W_WIN + 2ull * 4352 * 1024 * 2;
constexpr size_t W_WPB = W_WPA + 2ull * 1024 * 512 * 2;
constexpr size_t W_WOUT = W_WPB + 2ull * 1024 * 512 * 2;
constexpr size_t W_FF1 = W_WOUT + 2ull * 1024 * 1024 * 2;
constexpr size_t W_FF2 = W_FF1 + 2ull * 4096 * 1024 * 2;
constexpr size_t W_WSM = W_FF2 + 2ull * LDH * 1024 * 2;
constexpr size_t W_ROPE = W_WSM + 2ull * 4 * 128 * 128 * 2;
constexpr size_t W_XBF = W_ROPE + 4096ull * 16 * 4;
constexpr size_t W_BIG = W_XBF + (size_t)MT * 1024 * 2;
constexpr size_t W_Q = W_BIG;
constexpr size_t W_KP = W_Q + (size_t)MT * 512 * 2;
constexpr size_t W_VP = W_KP + (size_t)MP * 128 * 2;
constexpr size_t W_QI = W_VP + (size_t)MP * 128 * 2;
constexpr size_t W_KIP = W_QI + (size_t)MT * 256 * 2;
constexpr size_t W_KIRAW = W_KIP + (size_t)MP * 64 * 2;
constexpr size_t W_WI = W_KIRAW + (size_t)MT * 64 * 4;
constexpr size_t W_U = W_WI + (size_t)MT * 4 * 4;
constexpr size_t W_VG = W_U + (size_t)MT * 512 * 2;
constexpr size_t W_GA = W_VG + (size_t)MT * 512 * 2;
constexpr size_t W_GB = W_GA + (size_t)MT * 1024 * 2;
constexpr size_t W_BIGEND = W_GB + (size_t)MT * 1024 * 2;
constexpr size_t W_MRG = W_Q;
static_assert((size_t)MT * 1024 * 2 <= W_KIRAW - W_Q, "merged overlay");
constexpr size_t W_H = W_BIG;
static_assert((size_t)MT * LDH * 2 <= W_BIGEND - W_BIG, "H overlay");
constexpr size_t W_KS = W_BIGEND;
constexpr size_t W_VS = W_KS + 2ull * 16 * 2080 * 128 * 2;
constexpr size_t W_KIS = W_VS + 2ull * 16 * 2080 * 128 * 2;
constexpr size_t W_SEL = W_KIS + 2ull * 16 * 2080 * 64 * 2;
constexpr size_t W_OA = W_SEL + (size_t)MT * 256 * 2;
constexpr size_t W_PART = W_OA + (size_t)MT * 512 * 2;
constexpr size_t W_BAR = W_PART + 8ull * MS * 1024 * 4;
constexpr size_t W_END = W_BAR + 16384;

constexpr int LDS_BYTES = 139264 + 16;

struct Params {
  const float *x_prompt, *x_sample, *cache_k, *cache_v, *cache_ik, *w_in, *idx_g, *idx_b, *sgu_g, *sgu_b, *w_s, *b_s, *w_pa, *w_pb, *w_out,
      *ln1_g, *ln1_b, *w_ff1, *w_ff2, *ln2_g, *ln2_b;
  float* out;
  unsigned char* ws;
};

__device__ __forceinline__ unsigned cvt_pk_bf16(float lo, float hi) {
  unsigned r;
  asm volatile("v_cvt_pk_bf16_f32 %0, %1, %2" : "=v"(r) : "v"(lo), "v"(hi));
  return r;
}
template <class T> __device__ __forceinline__ T launder(T p) { asm volatile("" : "+s"(p)); return p; }
typedef const __attribute__((address_space(4))) Params* KP;
__device__ __forceinline__ int otid() { int t = threadIdx.x; asm volatile("" : "+v"(t)); return t; }
__device__ __forceinline__ float bflo(unsigned w) { return __uint_as_float(w << 16); }
__device__ __forceinline__ float bfhi(unsigned w) { return __uint_as_float(w & 0xffff0000u); }
__device__ __forceinline__ float bf2f(bf16_t b) { return __uint_as_float(((unsigned)b) << 16); }

__device__ __forceinline__ size_t kif_off(int key, int li  ) { return ((size_t)(((key >> 5) * 4 + (li >> 2)) * 64 + ((li >> 1) & 1) * 32 + (key & 31))) * 8 + (li & 1) * 4; }
enum { G_Q = 0, G_K, G_V, G_QI, G_KI, G_WI, G_U, G_VG, G_GA, G_GB, G_PAD };
__host__ __device__ __forceinline__ void slot_info(int S, int& grp, int& off) {
  if (S < 16) { grp = G_Q; off = 32 * S; }
  else if (S < 20) { grp = G_K; off = 32 * (S - 16); }
  else if (S < 24) { grp = G_V; off = 32 * (S - 20); }
  else if (S < 32) { grp = G_QI; off = 32 * (S - 24); }
  else if (S < 40) {
    if (S == 32) { grp = G_KI; off = 0; }
    else if (S == 33) { grp = G_WI; off = 0; }
    else if (S == 34) { grp = G_U; off = 0; }
    else if (S == 35) { grp = G_U; off = 32; }
    else if (S == 36) { grp = G_KI; off = 32; }
    else { grp = G_U; off = 32 * (S - 35); }
  }
  else if (S < 51) { grp = G_U; off = 32 * (S - 35); }
  else if (S < 67) { grp = G_VG; off = 32 * (S - 51); }
  else if (S < 99) { grp = G_GA; off = 32 * (S - 67); }
  else if (S < 131) { grp = G_GB; off = 32 * (S - 99); }
  else { grp = G_PAD; off = 0; }
}
__device__ __forceinline__ int win_orig_col(int p) {
  int grp, off;
  slot_info(p >> 5, grp, off);
  const int c = p & 31;
  switch (grp) {
    case G_Q: return off + c;
    case G_K: return 512 + off + c;
    case G_V: return 640 + off + c;
    case G_QI: return 768 + off + c;
    case G_KI: return 1024 + off + c;
    case G_WI: return c < 4 ? 1088 + c : -1;
    case G_U: return 1092 + off + c;
    case G_VG: return 1604 + off + c;
    case G_GA: return 2116 + off + c;
    case G_GB: return 3140 + off + c;
    default: return -1;
  }
}

namespace pg8 {
constexpr int BM = 256, BK = 64, HALF = 128, HTB = HALF * BK * 2, STAGE_BYTES = 8 * HTB, NXCD = 8, WGM = 8;
__host__ __device__ __forceinline__ int lds_byte(int r, int c) {
  const int st = (r >> 4) * 2 + (c >> 5), rr = r & 15, cc = c & 31, ob = rr * 64 + cc * 2;
  return st * 1024 + (ob ^ (((ob >> 9) & 1) << 5));
}
__host__ __device__ __forceinline__ void stage_rc(int b, int& R, int& C) {
  const int st = b / 1024, sb = b % 1024, swz = sb ^ (((sb >> 9) & 1) << 5);
  R = (st >> 1) * 16 + swz / 64;
  C = (st & 1) * 32 + (swz % 64) / 2;
}
__host__ __device__ __forceinline__ int perm32(int rho) { const int n = rho >> 4, i = rho & 15; return 8 * (i >> 2) + 4 * n + (i & 3); }
struct Unit { int pm, pn, kt0, nt, split, which; };
struct Gemm { const bf16_t* A; const bf16_t* Bt; int M, N, K, lda, ldb; const bf16_t* A2; const bf16_t* Bt2; };
struct StaticOrder {
  int nM, nN, nwg, nextra, splits, ntfull, G, c, dual;
  __device__ void init(int N, int K, int splits_, int G_, int c_) {
    nM = MP / BM; nN = N / BM; nwg = nM * nN; splits = splits_ > 0 ? splits_ : 1; nextra = 2 * nN * splits_; ntfull = K / BK; G = G_; c = c_; dual = 0;
  }
  __device__ bool next(int i, Unit& u) const {
    const long L = (long)(i >> dual) * G + c;
    u.which = dual ? (i & 1) : 0;
    if (L < nwg) {
      int wgid = (int)L;
      { const int q = nwg / NXCD, r = nwg % NXCD, xcd = wgid % NXCD, off = wgid / NXCD; wgid = (xcd < r ? xcd * (q + 1) : r * (q + 1) + (xcd - r) * q) + off; }
      const int nig = WGM * nN, gid = wgid / nig, fm = gid * WGM, gsz = (nM - fm) < WGM ? (nM - fm) : WGM;
      u.pm = fm + ((wgid % nig) % gsz);
      u.pn = (wgid % nig) / gsz;
      u.kt0 = 0; u.nt = ntfull; u.split = 0;
      return true;
    }
    const int j = (int)(L - nwg);
    if (j >= nextra) return false;
    const int per_panel = nN * splits;
    u.pm = nM + j / per_panel;
    const int rem = j % per_panel;
    u.pn = rem / splits;
    u.nt = ntfull / splits;
    u.kt0 = (rem % splits) * u.nt;
    u.split = splits > 1 ? 1 : 0;
    return true;
  }
};

template <class Epi>
__device__ __forceinline__ void gemm_phase(LAS unsigned char* lds, const Gemm g, const StaticOrder& S, const Epi& E) {
  const int tid = otid(), wid = __builtin_amdgcn_readfirstlane(tid >> 6), lane = tid & 63, wr = wid >> 2, wc = wid & 3, fr = lane & 15, fq = lane >> 4;
  const int K = g.K;
  unsigned voffA[2], voffB[2];
#pragma unroll
  for (int i = 0; i < 2; ++i) {
    int R, C;
    stage_rc(tid * 16 + i * 8192, R, C);
    const int Rb = Epi::PERM ? ((R & ~31) + perm32(R & 31)) : R;
    voffA[i] = (unsigned)(R * g.lda + C) * 2u;
    voffB[i] = (unsigned)(Rb * g.ldb + C) * 2u;
  }
  const size_t kstep = (size_t)(BK * 2);
  const size_t hstepA = (size_t)HALF * g.lda * 2, hstepB = (size_t)HALF * g.ldb * 2;
  const size_t tstepA = 2 * hstepA, tstepB = 2 * hstepB;
  const unsigned ldsw = (unsigned)wid * 1024u;
  const int aoff = lds_byte(wr * 64 + fr, fq * 8), boff = lds_byte(wc * 32 + fr, fq * 8);
#define PG8_SA(b, h) (((b) * 2 + (h)) * HTB)
#define PG8_SB(b, h) ((4 + (b) * 2 + (h)) * HTB)
#define PG8_STAGE(bufoff, gbase, voff) do { _Pragma("unroll") for (int _i = 0; _i < 2; ++_i) \
    __builtin_amdgcn_global_load_lds((const unsigned*)((const char*)(gbase) + (voff)[_i]), (LAS unsigned*)(lds + (bufoff) + ldsw + _i * 8192), 16, 0, 0); } while (0)
#define PG8_LDA(dst, b, h) do { _Pragma("unroll") for (int m = 0; m < 4; ++m) _Pragma("unroll") for (int k = 0; k < 2; ++k) dst[m][k] = *(const LAS bf16x8*)(lds + PG8_SA(b, h) + aoff + m * 2048 + k * 1024); } while (0)
#define PG8_LDB(dst, b, h) do { _Pragma("unroll") for (int n = 0; n < 2; ++n) _Pragma("unroll") for (int k = 0; k < 2; ++k) dst[n][k] = *(const LAS bf16x8*)(lds + PG8_SB(b, h) + boff + n * 2048 + k * 1024); } while (0)
#define PG8_MMA(ai, bj, At, Bt) do { __builtin_amdgcn_s_setprio(1); _Pragma("unroll") for (int m = 0; m < 4; ++m) _Pragma("unroll") for (int n = 0; n < 2; ++n) _Pragma("unroll") for (int k = 0; k < 2; ++k) \
    acc[ai][bj][m][n] = __builtin_amdgcn_mfma_f32_16x16x32_bf16(Bt[n][k], At[m][k], acc[ai][bj][m][n], 0, 0, 0); __builtin_amdgcn_s_setprio(0); } while (0)
#define PG8_WAIT_V(n) asm volatile("s_waitcnt vmcnt(" #n ")" ::: "memory")
#define PG8_WAIT_L(n) asm volatile("s_waitcnt lgkmcnt(" #n ")" ::: "memory")
#define PG8_BAR __builtin_amdgcn_s_barrier()
#define PG8_SCHED __builtin_amdgcn_sched_barrier(0)
  Unit cur, nxt;
  int ui = 0;
  if (!S.next(0, cur)) return;
  f32x4 acc[2][2][4][2];
#pragma unroll
  for (int a = 0; a < 2; ++a)
#pragma unroll
    for (int b = 0; b < 2; ++b)
#pragma unroll
      for (int m = 0; m < 4; ++m)
#pragma unroll
        for (int n = 0; n < 2; ++n) acc[a][b][m][n] = (f32x4){0.f, 0.f, 0.f, 0.f};
  bf16x8 At[4][2], B0[2][2], B1[2][2];
  const char* cA = (const char*)(cur.which ? g.A2 : g.A) + (size_t)cur.pm * tstepA + (size_t)cur.kt0 * kstep;
  const char* cB = (const char*)(cur.which ? g.Bt2 : g.Bt) + (size_t)cur.pn * tstepB + (size_t)cur.kt0 * kstep;
  PG8_STAGE(PG8_SB(0, 0), cB, voffB); PG8_STAGE(PG8_SA(0, 0), cA, voffA); PG8_STAGE(PG8_SB(0, 1), cB + hstepB, voffB); PG8_STAGE(PG8_SA(0, 1), cA + hstepA, voffA);
  if (wr == 1) PG8_BAR;
  PG8_WAIT_V(4); PG8_BAR;
  PG8_STAGE(PG8_SB(1, 0), cB + kstep, voffB); PG8_STAGE(PG8_SA(1, 0), cA + kstep, voffA); PG8_STAGE(PG8_SB(1, 1), cB + hstepB + kstep, voffB);
  PG8_WAIT_V(6); PG8_BAR;
  for (;;) {
    const bool has_next = S.next(ui + 1, nxt);
    const char* nA = has_next ? (const char*)(nxt.which ? g.A2 : g.A) + (size_t)nxt.pm * tstepA + (size_t)nxt.kt0 * kstep : cA;
    const char* nB = has_next ? (const char*)(nxt.which ? g.Bt2 : g.Bt) + (size_t)nxt.pn * tstepB + (size_t)nxt.kt0 * kstep : cB;
    const int nt = cur.nt;
    for (int t = 0; t < nt; t += 2) {
      const bool last = (t == nt - 2);
      const char* a1 = cA + (size_t)(t + 1) * kstep;
      const char* a2 = last ? nA : cA + (size_t)(t + 2) * kstep;
      const char* b2 = last ? nB : cB + (size_t)(t + 2) * kstep;
      const char* a3 = a2 + kstep;
      const char* b3 = b2 + kstep;
      PG8_LDB(B0, 0, 0); PG8_SCHED; PG8_LDA(At, 0, 0); PG8_STAGE(PG8_SA(1, 1), a1 + hstepA, voffA);
      PG8_WAIT_L(8); PG8_BAR; PG8_WAIT_L(0); PG8_MMA(0, 0, At, B0); PG8_BAR; PG8_SCHED;
      PG8_LDB(B1, 0, 1); PG8_STAGE(PG8_SB(0, 0), b2, voffB);
      PG8_BAR; PG8_WAIT_L(0); PG8_MMA(0, 1, At, B1); PG8_BAR;
      PG8_LDA(At, 0, 1); PG8_STAGE(PG8_SA(0, 0), a2, voffA);
      PG8_BAR; PG8_WAIT_L(0); PG8_MMA(1, 0, At, B0); PG8_BAR; PG8_SCHED;
      PG8_STAGE(PG8_SB(0, 1), b2 + hstepB, voffB);
      PG8_WAIT_V(6); PG8_BAR; PG8_MMA(1, 1, At, B1); PG8_BAR;
      PG8_LDB(B0, 1, 0); PG8_SCHED; PG8_LDA(At, 1, 0); PG8_STAGE(PG8_SA(0, 1), a2 + hstepA, voffA);
      PG8_WAIT_L(8); PG8_BAR; PG8_WAIT_L(0); PG8_MMA(0, 0, At, B0); PG8_BAR; PG8_SCHED;
      PG8_LDB(B1, 1, 1); PG8_STAGE(PG8_SB(1, 0), b3, voffB);
      PG8_BAR; PG8_WAIT_L(0); PG8_MMA(0, 1, At, B1); PG8_BAR;
      PG8_LDA(At, 1, 1); PG8_STAGE(PG8_SA(1, 0), a3, voffA);
      PG8_BAR; PG8_WAIT_L(0); PG8_MMA(1, 0, At, B0); PG8_BAR; PG8_SCHED;
      PG8_STAGE(PG8_SB(1, 1), b3 + hstepB, voffB);
      PG8_WAIT_V(6); PG8_BAR; PG8_MMA(1, 1, At, B1); PG8_BAR;
    }
    E(acc, cur, wr, wc, fr, fq);
    if (!has_next) break;
#pragma unroll
    for (int a = 0; a < 2; ++a)
#pragma unroll
      for (int b = 0; b < 2; ++b)
#pragma unroll
        for (int m = 0; m < 4; ++m)
#pragma unroll
          for (int n = 0; n < 2; ++n) acc[a][b][m][n] = (f32x4){0.f, 0.f, 0.f, 0.f};
    cur = nxt; cA = nA; cB = nB; ++ui;
  }
  PG8_WAIT_V(0);
  if (wr == 0) PG8_BAR;
  PG8_BAR;
#undef PG8_SA
#undef PG8_SB
#undef PG8_STAGE
#undef PG8_LDA
#undef PG8_LDB
#undef PG8_MMA
#undef PG8_WAIT_V
#undef PG8_WAIT_L
#undef PG8_BAR
#undef PG8_SCHED
}
}
using pg8::Unit;

struct EpiIn {
  static constexpr bool PERM = true;
  int l;
  float* out;
  unsigned char* ws;
  static __device__ __forceinline__ void rot_mul(f32x4 (&a)[4], const f32x4 (&b)[4]) {
#pragma unroll
    for (int e = 0; e < 4; ++e) {
      const f32x4 x = a[e], y = b[e];
      a[e] = (f32x4){x[0] * y[0] - x[1] * y[1], x[1] * y[0] + x[0] * y[1], x[2] * y[2] - x[3] * y[3], x[3] * y[2] + x[2] * y[3]};
    }
  }
  template <int CAT>
  __device__ __forceinline__ void slot(const f32x4 (&acc)[2][2][4][2], int bj, int r00, int p0, bool sunit, int fq, int c0, bf16_t* bdst, int bstride, float* fdst,
                                       float scale) const {
    const float* rope = (const float*)(ws + W_ROPE);
    const f32x4 r16[4] = {{-9.576594803e-01f, -2.879033167e-01f, -9.992462583e-01f, 3.881900626e-02f}, {8.243765167e-01f, 5.660418348e-01f, 9.932003015e-01f, 1.164180448e-01f}, {9.997440109e-01f, 2.262548617e-02f, 9.999903729e-01f, 4.387956933e-03f}, {9.999996380e-01f, 8.509272148e-04f, 9.999999864e-01f, 1.650141632e-04f}};
#pragma unroll
    for (int ai = 0; ai < 2; ++ai) {
      f32x4 csa[4];
      if (CAT == 0) {
        const int pa = sunit ? p0 : p0 + 128 * ai;
#pragma unroll
        for (int e = 0; e < 4; ++e) csa[e] = *(const f32x4*)(rope + (size_t)pa * 16 + e * 4);
      }
#pragma unroll
      for (int m = 0; m < 4; ++m) {
        const int r = r00 + ai * 128 + m * 16;
        const int sr = r - MP;
        float v[8];
#pragma unroll
        for (int e = 0; e < 4; ++e) {
          v[e] = bj == 0 ? acc[ai][0][m][0][e] : acc[ai][1][m][0][e];
          v[4 + e] = bj == 0 ? acc[ai][0][m][1][e] : acc[ai][1][m][1][e];
        }
        if (CAT == 0) {
          if (m == 2 && sunit) {
#pragma unroll
            for (int e = 0; e < 4; ++e) csa[e] = *(const f32x4*)(rope + (size_t)p0 * 16 + e * 4);
          }
          float pr[8];
#pragma unroll
          for (int e = 0; e < 8; ++e) pr[e] = __shfl_xor(v[e], 16);
          if (fq < 2) {
#pragma unroll
            for (int e2 = 0; e2 < 4; ++e2) {
              const f32x4 t = csa[e2];
              if (fq == 0) {
                v[2 * e2] = v[2 * e2] * t[0] - pr[2 * e2] * t[1];
                v[2 * e2 + 1] = v[2 * e2 + 1] * t[2] - pr[2 * e2 + 1] * t[3];
              } else {
                v[2 * e2] = pr[2 * e2] * t[1] + v[2 * e2] * t[0];
                v[2 * e2 + 1] = pr[2 * e2 + 1] * t[3] + v[2 * e2 + 1] * t[2];
              }
            }
          }
          if (m < 3) rot_mul(csa, r16);
        }
        if (CAT == 2) {
          unsigned q[8];
#pragma unroll
          for (int e = 0; e < 8; ++e) q[e] = (unsigned)(__frcp_rn(1.f + __expf(-v[e])) * 255.f + 0.5f);
          u32x2 w8;
          w8[0] = q[0] | (q[1] << 8) | (q[2] << 16) | (q[3] << 24);
          w8[1] = q[4] | (q[5] << 8) | (q[6] << 16) | (q[7] << 24);
          *(u32x2*)((unsigned char*)bdst + (size_t)r * 1024 + c0) = w8;
          continue;
        }
        if (CAT == 3) {
          float* d = (float*)(ws + W_KIRAW) + (size_t)r * 64 + c0;
          *(f32x4*)d = (f32x4){v[0], v[1], v[2], v[3]};
          *(f32x4*)(d + 4) = (f32x4){v[4], v[5], v[6], v[7]};
        } else if (CAT == 4) {
          if (fq == 0) *(f32x4*)((float*)(ws + W_WI) + (size_t)r * 4) = (f32x4){v[0] * 0.5f, v[1] * 0.5f, v[2] * 0.5f, v[3] * 0.5f};
        } else {
          u32x4 w;
#pragma unroll
          for (int e = 0; e < 4; ++e) w[e] = cvt_pk_bf16(v[2 * e] * scale, v[2 * e + 1] * scale);
          size_t brow = (size_t)r;
          if (fdst && sunit) brow = (size_t)(l * 16 + (sr >> 5)) * 2080 + 2048 + (sr & 31);
          *(u32x4*)(bdst + brow * bstride + c0) = w;
          if (fdst) {
            float* fp = fdst + ((size_t)(sunit ? l * MS + sr : l * MP + r)) * 128 + c0;
            *(f32x4*)fp = (f32x4){v[0], v[1], v[2], v[3]};
            *(f32x4*)(fp + 4) = (f32x4){v[4], v[5], v[6], v[7]};
          }
        }
        if (CAT == 0) __builtin_amdgcn_sched_barrier(0);
      }
    }
  }
  __device__ __forceinline__ void operator()(const f32x4 (&acc)[2][2][4][2], const Unit& u, int wr, int wc, int fr, int fq) const {
    const bool sunit = u.pm >= MP / 256;
    const int r00 = u.pm * 256 + wr * 64 + fr;
    const int p0 = sunit ? 2048 + fr : (r00 & 4095);
#pragma unroll
    for (int bj = 0; bj < 2; ++bj) {
      int grp, off;
      slot_info(u.pn * 8 + bj * 4 + wc, grp, off);
      if (grp == G_PAD) continue;
      const int c0 = off + 8 * fq;
      const bool dorope = (grp == G_Q || grp == G_K || grp == G_QI) && ((off & 63) == 0);
      const float scale = (grp == G_Q || grp == G_QI) ? 0.125f : 1.0f;
      bf16_t* bdst;
      int bstride;
      float* fdst = nullptr;
      switch (grp) {
        case G_Q: bdst = (bf16_t*)(ws + W_Q); bstride = 512; break;
        case G_QI: bdst = (bf16_t*)(ws + W_QI); bstride = 256; break;
        case G_K: bdst = (bf16_t*)(ws + (sunit ? W_KS : W_KP)); bstride = 128; fdst = out + (sunit ? O_SK : O_PK); break;
        case G_V: bdst = (bf16_t*)(ws + (sunit ? W_VS : W_VP)); bstride = 128; fdst = out + (sunit ? O_SV : O_PV); break;
        case G_U: bdst = (bf16_t*)(ws + W_U); bstride = 512; break;
        case G_VG: bdst = (bf16_t*)(ws + W_VG); bstride = 512; break;
        case G_GA: bdst = (bf16_t*)(ws + W_GA); bstride = 1024; break;
        case G_GB: bdst = (bf16_t*)(ws + W_GB); bstride = 1024; break;
        default: bdst = nullptr; bstride = 0; break;
      }
      if (dorope) slot<0>(acc, bj, r00, p0, sunit, fq, c0, bdst, bstride, fdst, scale);
      else if (grp == G_GA || grp == G_GB) slot<2>(acc, bj, r00, p0, sunit, fq, c0, bdst, bstride, fdst, scale);
      else if (grp == G_KI) slot<3>(acc, bj, r00, p0, sunit, fq, c0, bdst, bstride, fdst, scale);
      else if (grp == G_WI) slot<4>(acc, bj, r00, p0, sunit, fq, c0, bdst, bstride, fdst, scale);
      else slot<1>(acc, bj, r00, p0, sunit, fq, c0, bdst, bstride, fdst, scale);
    }
  }
};

struct EpiGate {
  static constexpr bool PERM = true;
  const unsigned char* ga;
  const unsigned char* gb;
  bf16_t* mrg;
  __device__ __forceinline__ void operator()(const f32x4 (&acc)[2][2][4][2], const Unit& u, int wr, int wc, int fr, int fq) const {
    const unsigned char* gate = u.which ? gb : ga;
#pragma unroll
    for (int ai = 0; ai < 2; ++ai) {
      u32x2 gw[4][2];
      u32x4 pw[4][2];
#pragma unroll
      for (int m = 0; m < 4; ++m)
#pragma unroll
        for (int bj = 0; bj < 2; ++bj) {
          const size_t o = (size_t)(u.pm * 256 + ai * 128 + wr * 64 + m * 16 + fr) * 1024 + u.pn * 256 + bj * 128 + wc * 32 + 8 * fq;
          gw[m][bj] = *(const u32x2*)(gate + o);
          pw[m][bj] = (u32x4){0u, 0u, 0u, 0u};
          if (u.which) pw[m][bj] = *(const u32x4*)(mrg + o);
        }
#pragma unroll
      for (int m = 0; m < 4; ++m)
#pragma unroll
        for (int bj = 0; bj < 2; ++bj) {
          const size_t o = (size_t)(u.pm * 256 + ai * 128 + wr * 64 + m * 16 + fr) * 1024 + u.pn * 256 + bj * 128 + wc * 32 + 8 * fq;
          float v[8];
#pragma unroll
          for (int e = 0; e < 8; ++e) v[e] = (float)((gw[m][bj][e >> 2] >> (8 * (e & 3))) & 0xffu) * (1.f / 255.f) * acc[ai][bj][m][e >> 2][e & 3];
#pragma unroll
          for (int e = 0; e < 4; ++e) { v[2 * e] += bflo(pw[m][bj][e]); v[2 * e + 1] += bfhi(pw[m][bj][e]); }
          u32x4 w;
#pragma unroll
          for (int e = 0; e < 4; ++e) w[e] = cvt_pk_bf16(v[2 * e], v[2 * e + 1]);
          *(u32x4*)(mrg + o) = w;
        }
    }
  }
};

struct EpiRes {
  static constexpr bool PERM = false;
  const float* xp;
  const bf16_t* xb;
  float* R;
  float* part;
  __device__ __forceinline__ void operator()(const f32x4 (&acc)[2][2][4][2], const Unit& u, int wr, int wc, int fr, int fq) const {
    if (u.split) {
      float* pbase = part + (size_t)(u.kt0 / u.nt) * MS * 1024;
#pragma unroll
      for (int ai = 0; ai < 2; ++ai)
#pragma unroll
        for (int m = 0; m < 4; ++m) {
          float* orow = pbase + (size_t)(u.pm * 256 + ai * 128 + wr * 64 + m * 16 + fr - MP) * 1024;
#pragma unroll
          for (int bj = 0; bj < 2; ++bj)
#pragma unroll
            for (int n = 0; n < 2; ++n) *(f32x4*)(orow + u.pn * 256 + bj * 128 + wc * 32 + 16 * n + 4 * fq) = acc[ai][bj][m][n];
        }
      return;
    }
    if (xp) {
#pragma unroll
      for (int ai = 0; ai < 2; ++ai)
#pragma unroll
        for (int mp = 0; mp < 2; ++mp) {
          f32x4 xr[2][2][2];
#pragma unroll
          for (int mm = 0; mm < 2; ++mm)
#pragma unroll
            for (int bj = 0; bj < 2; ++bj)
#pragma unroll
              for (int n = 0; n < 2; ++n)
                xr[mm][bj][n] = *(const f32x4*)(xp + (size_t)(u.pm * 256 + ai * 128 + wr * 64 + (mp * 2 + mm) * 16 + fr) * 1024 + u.pn * 256 + bj * 128 + wc * 32 + 16 * n + 4 * fq);
#pragma unroll
          for (int mm = 0; mm < 2; ++mm)
#pragma unroll
            for (int bj = 0; bj < 2; ++bj)
#pragma unroll
              for (int n = 0; n < 2; ++n) {
                const size_t o = (size_t)(u.pm * 256 + ai * 128 + wr * 64 + (mp * 2 + mm) * 16 + fr) * 1024 + u.pn * 256 + bj * 128 + wc * 32 + 16 * n + 4 * fq;
                *(f32x4*)(R + o) = xr[mm][bj][n] * ALPHA + acc[ai][bj][mp * 2 + mm][n];
              }
        }
    } else {
      u32x2 xr[2][4][2][2];
#pragma unroll
      for (int ai = 0; ai < 2; ++ai)
#pragma unroll
        for (int m = 0; m < 4; ++m)
#pragma unroll
          for (int bj = 0; bj < 2; ++bj)
#pragma unroll
            for (int n = 0; n < 2; ++n)
              xr[ai][m][bj][n] = *(const u32x2*)(xb + (size_t)(u.pm * 256 + ai * 128 + wr * 64 + m * 16 + fr) * 1024 + u.pn * 256 + bj * 128 + wc * 32 + 16 * n + 4 * fq);
#pragma unroll
      for (int ai = 0; ai < 2; ++ai)
#pragma unroll
        for (int m = 0; m < 4; ++m)
#pragma unroll
          for (int bj = 0; bj < 2; ++bj)
#pragma unroll
            for (int n = 0; n < 2; ++n) {
              const size_t o = (size_t)(u.pm * 256 + ai * 128 + wr * 64 + m * 16 + fr) * 1024 + u.pn * 256 + bj * 128 + wc * 32 + 16 * n + 4 * fq;
              const u32x2 xw = xr[ai][m][bj][n];
              const f32x4 x = (f32x4){bflo(xw[0]), bfhi(xw[0]), bflo(xw[1]), bfhi(xw[1])};
              *(f32x4*)(R + o) = x * ALPHA + acc[ai][bj][m][n];
            }
    }
  }
};

struct EpiFF1 {
  static constexpr bool PERM = true;
  bf16_t* H;
  __device__ __forceinline__ void operator()(const f32x4 (&acc)[2][2][4][2], const Unit& u, int wr, int wc, int fr, int fq) const {
#pragma unroll
    for (int ai = 0; ai < 2; ++ai)
#pragma unroll
      for (int m = 0; m < 4; ++m) {
        const int r = u.pm * 256 + ai * 128 + wr * 64 + m * 16 + fr;
#pragma unroll
        for (int bj = 0; bj < 2; ++bj) {
          float v[8];
#pragma unroll
          for (int e = 0; e < 4; ++e) {
            const float a = fmaxf(acc[ai][bj][m][0][e], 0.f), b = fmaxf(acc[ai][bj][m][1][e], 0.f);
            v[e] = a * a; v[4 + e] = b * b;
          }
          u32x4 w;
#pragma unroll
          for (int e = 0; e < 4; ++e) w[e] = cvt_pk_bf16(v[2 * e], v[2 * e + 1]);
          *(u32x4*)(H + (size_t)r * LDH + u.pn * 256 + bj * 128 + wc * 32 + 8 * fq) = w;
        }
      }
  }
};

__device__ __forceinline__ void cvt_rows(const float* __restrict__ src, bf16_t* __restrict__ dst, size_t n4, size_t gtid, size_t gn) {
  for (size_t i0 = gtid; i0 < n4; i0 += 4 * gn) {
    f32x4 v[4];
#pragma unroll
    for (int q = 0; q < 4; ++q) { const size_t i = i0 + q * gn; v[q] = i < n4 ? *(const f32x4*)(src + i * 4) : (f32x4){0.f, 0.f, 0.f, 0.f}; }
#pragma unroll
    for (int q = 0; q < 4; ++q) {
      const size_t i = i0 + q * gn;
      if (i < n4) { u32x2 w; w[0] = cvt_pk_bf16(v[q][0], v[q][1]); w[1] = cvt_pk_bf16(v[q][2], v[q][3]); *(u32x2*)(dst + i * 4) = w; }
    }
  }
}

struct TTile { const float* src; bf16_t* dst; int ldsrc, K, k0, n0; bool winmap; };
__device__ __forceinline__ TTile prep_tile(KP kp, unsigned char* ws, int j) {
  TTile t;
  t.winmap = false;
  int jj = j;
  if (jj < 2176) {
    const int l = jj / 1088, q = jj % 1088;
    t.src = kp->w_in + (size_t)l * 1024 * 4164; t.ldsrc = 4164; t.dst = (bf16_t*)(ws + W_WIN) + (size_t)l * 4352 * 1024; t.K = 1024; t.n0 = (q / 16) * 64; t.k0 = (q % 16) * 64; t.winmap = true;
    return t;
  }
  jj -= 2176;
  if (jj < 512) {
    const int which = jj / 256, t2 = jj % 256, l = t2 / 128, q = t2 % 128;
    t.src = (which ? kp->w_pb : kp->w_pa) + (size_t)l * 512 * 1024; t.ldsrc = 1024; t.dst = (bf16_t*)(ws + (which ? W_WPB : W_WPA)) + (size_t)l * 1024 * 512; t.K = 512; t.n0 = (q / 8) * 64; t.k0 = (q % 8) * 64;
    return t;
  }
  jj -= 512;
  if (jj < 512) {
    const int l = jj / 256, q = jj % 256;
    t.src = kp->w_out + (size_t)l * 1024 * 1024; t.ldsrc = 1024; t.dst = (bf16_t*)(ws + W_WOUT) + (size_t)l * 1024 * 1024; t.K = 1024; t.n0 = (q / 16) * 64; t.k0 = (q % 16) * 64;
    return t;
  }
  jj -= 512;
  if (jj < 2048) {
    const int l = jj / 1024, q = jj % 1024;
    t.src = kp->w_ff1 + (size_t)l * 1024 * 4096; t.ldsrc = 4096; t.dst = (bf16_t*)(ws + W_FF1) + (size_t)l * 4096 * 1024; t.K = 1024; t.n0 = (q / 16) * 64; t.k0 = (q % 16) * 64;
    return t;
  }
  jj -= 2048;
  {
    const int l = jj / 1024, q = jj % 1024;
    t.src = kp->w_ff2 + (size_t)l * 4096 * 1024; t.ldsrc = 1024; t.dst = (bf16_t*)(ws + W_FF2) + (size_t)l * 1024 * LDH; t.K = LDH; t.n0 = (q / 64) * 64; t.k0 = (q % 64) * 64;
  }
  return t;
}
__device__ __forceinline__ void phase_prep(KP kp, unsigned char* shm) {
  kp = launder(kp);
  float* tl = (float*)shm;
  const int bid = blockIdx.x, nb = gridDim.x, tid = otid();
  unsigned char* ws = kp->ws;
  for (int j0 = bid * 4; j0 < 7296; j0 += nb * 4) {
    float v[4][8];
#pragma unroll
    for (int q = 0; q < 4; ++q) {
      const TTile t = prep_tile(kp, ws, j0 + q);
#pragma unroll
      for (int e = 0; e < 8; ++e) {
        const int idx = tid + e * 512, r = idx >> 6, c = idx & 63;
        const int oc = t.winmap ? win_orig_col(t.n0 + c) : (t.n0 + c);
        v[q][e] = oc >= 0 ? t.src[(size_t)(t.k0 + r) * t.ldsrc + oc] : 0.f;
      }
    }
#pragma unroll
    for (int q = 0; q < 4; ++q)
#pragma unroll
      for (int e = 0; e < 8; ++e) {
        const int idx = tid + e * 512, r = idx >> 6, c = idx & 63;
        tl[q * 4160 + c * 65 + r] = v[q][e];
      }
    __syncthreads();
#pragma unroll
    for (int q = 0; q < 4; ++q) {
      const TTile t = prep_tile(kp, ws, j0 + q);
#pragma unroll
      for (int e = 0; e < 4; ++e) {
        const int idx = tid + e * 512, n = idx >> 5, kk = (idx & 31) * 2;
        *(unsigned*)(t.dst + (size_t)(t.n0 + n) * t.K + t.k0 + kk) = cvt_pk_bf16(tl[q * 4160 + n * 65 + kk], tl[q * 4160 + n * 65 + kk + 1]);
      }
    }
    __syncthreads();
  }
  const size_t gtid = (size_t)bid * 512 + tid, gn = (size_t)nb * 512;
  cvt_rows(kp->x_prompt, (bf16_t*)(ws + W_XBF), (size_t)MP * 256, gtid, gn);
  cvt_rows(kp->x_sample, (bf16_t*)(ws + W_XBF) + (size_t)MP * 1024, (size_t)MS * 256, gtid, gn);
  for (size_t i = gtid; i < (size_t)MS * 256; i += gn)
    *(f32x4*)(kp->out + O_Y + (size_t)MP * 1024 + i * 4) = *(const f32x4*)(kp->x_sample + i * 4) * ALPHA;
  for (size_t i0 = gtid; i0 < 2ull * 16 * 2048 * 32; i0 += 4 * gn) {
    f32x4 a[4], b[4];
#pragma unroll
    for (int q = 0; q < 4; ++q) {
      const size_t i = i0 + q * gn;
      const bool ok = i < 2ull * 16 * 2048 * 32;
      a[q] = ok ? *(const f32x4*)(kp->cache_k + i * 4) : (f32x4){0.f, 0.f, 0.f, 0.f};
      b[q] = ok ? *(const f32x4*)(kp->cache_v + i * 4) : (f32x4){0.f, 0.f, 0.f, 0.f};
    }
#pragma unroll
    for (int q = 0; q < 4; ++q) {
      const size_t i = i0 + q * gn;
      if (i < 2ull * 16 * 2048 * 32) {
        const size_t row = i >> 5, c4 = i & 31, lsb = row >> 11, rr = row & 2047;
        const size_t d = (lsb * 2080 + rr) * 128 + c4 * 4;
        u32x2 w;
        w[0] = cvt_pk_bf16(a[q][0], a[q][1]); w[1] = cvt_pk_bf16(a[q][2], a[q][3]);
        *(u32x2*)((bf16_t*)(ws + W_KS) + d) = w;
        w[0] = cvt_pk_bf16(b[q][0], b[q][1]); w[1] = cvt_pk_bf16(b[q][2], b[q][3]);
        *(u32x2*)((bf16_t*)(ws + W_VS) + d) = w;
      }
    }
  }
  for (size_t i0 = gtid; i0 < 2ull * 16 * 2048 * 16; i0 += 4 * gn) {
    f32x4 a[4];
#pragma unroll
    for (int q = 0; q < 4; ++q) { const size_t i = i0 + q * gn; a[q] = i < 2ull * 16 * 2048 * 16 ? *(const f32x4*)(kp->cache_ik + i * 4) : (f32x4){0.f, 0.f, 0.f, 0.f}; }
#pragma unroll
    for (int q = 0; q < 4; ++q) {
      const size_t i = i0 + q * gn;
      if (i < 2ull * 16 * 2048 * 16) {
        const size_t row = i >> 4, c4 = i & 15, lsb = row >> 11, rr = row & 2047;
        u32x2 w;
        w[0] = cvt_pk_bf16(a[q][0], a[q][1]); w[1] = cvt_pk_bf16(a[q][2], a[q][3]);
        *(u32x2*)((bf16_t*)(ws + W_KIS) + lsb * 2080 * 64 + kif_off((int)rr, (int)c4)) = w;
      }
    }
  }
  for (size_t i = gtid; i < 4096 * 8; i += gn) {
    const int pos = (int)(i >> 3), fi = (int)(i & 7);
    const float fr[8] = {1.0f, 0.1939227432012558f, 0.03760603070259094f, 0.007292664609849453f, 0.0014142135623842478f, 0.00027424818836152554f,
                         5.3182957344688475e-05f, 1.0313385246263351e-05f};
    float f = fr[0];
#pragma unroll
    for (int q = 1; q < 8; ++q) f = (fi == q) ? fr[q] : f;
    const float ang = (float)pos * f;
    double rev = (double)ang * 0.15915494309189535;
    rev -= floor(rev);
    const float t = (float)rev;
    float* d = (float*)(ws + W_ROPE) + i * 2;
    d[0] = __builtin_amdgcn_cosf(t);
    d[1] = __builtin_amdgcn_sinf(t);
  }
  for (size_t i = gtid; i < 2ull * 4 * 128 * 128; i += gn) {
    const int s = (int)(i & 127), t = (int)((i >> 7) & 127);
    const float v = s <= t ? kp->w_s[i] : 0.f;
    ((bf16_t*)(ws + W_WSM))[i] = (bf16_t)(cvt_pk_bf16(v, 0.f) & 0xffffu);
  }
}

__device__ __forceinline__ void phase_fix(KP kp, int l, unsigned char* shm) {
  kp = launder(kp);
  const int tid = otid(), lane = tid & 63, w = tid >> 6, bid = blockIdx.x, nb = gridDim.x;
  unsigned char* ws = kp->ws;
  const float* rope = (const float*)(ws + W_ROPE);
  {
    const int li = tid & 15;
    const f32x4 gg = *(const f32x4*)(kp->idx_g + l * 64 + li * 4), bb = *(const f32x4*)(kp->idx_b + l * 64 + li * 4);
    for (int rb = bid * 32; rb < MT; rb += nb * 32) {
      const int r = rb + (tid >> 4);
      const bool samp = r >= MP;
      const int sr = r - MP;
      const int pos = samp ? 2048 + (sr & 31) : (r & 4095);
      const f32x4 x = *(const f32x4*)((const float*)(ws + W_KIRAW) + (size_t)r * 64 + li * 4);
      float s = x[0] + x[1] + x[2] + x[3];
      s += __shfl_xor(s, 1); s += __shfl_xor(s, 2); s += __shfl_xor(s, 4); s += __shfl_xor(s, 8);
      const float mean = s * (1.f / 64.f);
      const f32x4 d = x - mean;
      float ss = d[0] * d[0] + d[1] * d[1] + d[2] * d[2] + d[3] * d[3];
      ss += __shfl_xor(ss, 1); ss += __shfl_xor(ss, 2); ss += __shfl_xor(ss, 4); ss += __shfl_xor(ss, 8);
      const float rstd = rsqrtf(ss * (1.f / 64.f) + LN_EPS);
      f32x4 y = d * rstd * gg + bb;
      f32x4 pr;
#pragma unroll
      for (int e = 0; e < 4; ++e) pr[e] = __shfl_xor(y[e], 2);
      if (li < 4) {
        const int i0 = (li & 1) * 4;
        const f32x4 t0 = *(const f32x4*)(rope + (size_t)pos * 16 + i0 * 2), t1 = *(const f32x4*)(rope + (size_t)pos * 16 + i0 * 2 + 4);
        const float cc[4] = {t0[0], t0[2], t1[0], t1[2]}, sn[4] = {t0[1], t0[3], t1[1], t1[3]};
#pragma unroll
        for (int e = 0; e < 4; ++e) y[e] = (li < 2) ? (y[e] * cc[e] - pr[e] * sn[e]) : (pr[e] * sn[e] + y[e] * cc[e]);
      }
      u32x2 wv;
      wv[0] = cvt_pk_bf16(y[0], y[1]); wv[1] = cvt_pk_bf16(y[2], y[3]);
      if (!samp) {
        *(f32x4*)(kp->out + O_PIK + ((size_t)l * MP + r) * 64 + li * 4) = y;
        *(u32x2*)((bf16_t*)(ws + W_KIP) + (size_t)(r >> 12) * 4096 * 64 + kif_off(r & 4095, li)) = wv;
      } else {
        *(f32x4*)(kp->out + O_SIK + ((size_t)l * MS + sr) * 64 + li * 4) = y;
        *(u32x2*)((bf16_t*)(ws + W_KIS) + (size_t)(l * 16 + (sr >> 5)) * 2080 * 64 + kif_off(2048 + (sr & 31), li)) = wv;
      }
    }
  }
  bf16_t* vnT = (bf16_t*)shm;
  const bf16_t* VG = (const bf16_t*)(ws + W_VG);
  bf16_t* U = (bf16_t*)(ws + W_U);
  const bf16_t* WSM = (const bf16_t*)(ws + W_WSM) + (size_t)l * 4 * 128 * 128;
  for (int tile = bid; tile < 272; tile += nb) {
    const bool samp = tile >= 256;
    const int rbase = samp ? MP + (tile - 256) * 32 : tile * 128;
    const int nrows = samp ? 32 : 128;
    {
      const int row = tid >> 2, qtr = tid & 3;
      if (row < nrows) {
        const bf16_t* src = VG + (size_t)(rbase + row) * 512 + qtr * 128;
        float s = 0.f, ss = 0.f;
#pragma unroll 4
        for (int e = 0; e < 16; ++e) {
          const u32x4 rw = *(const u32x4*)(src + e * 8);
#pragma unroll
          for (int q = 0; q < 4; ++q) { const float a = bflo(rw[q]), b = bfhi(rw[q]); s += a + b; ss += a * a + b * b; }
        }
        s += __shfl_xor(s, 1); s += __shfl_xor(s, 2);
        ss += __shfl_xor(ss, 1); ss += __shfl_xor(ss, 2);
        const float mean = s * (1.f / 512.f);
        const float var = fmaxf(ss * (1.f / 512.f) - mean * mean, 0.f);
        const float rstd = rsqrtf(var + LN_EPS);
        const float* gp = kp->sgu_g + l * 512 + qtr * 128;
        const float* bp = kp->sgu_b + l * 512 + qtr * 128;
        float* so = kp->out + O_SSV + ((size_t)l * MS + (rbase - MP) + row) * 512 + qtr * 128;
#pragma unroll 2
        for (int e = 0; e < 16; ++e) {
          const u32x4 rw = *(const u32x4*)(src + e * 8);
          const f32x4 g0 = *(const f32x4*)(gp + e * 8), g1 = *(const f32x4*)(gp + e * 8 + 4);
          const f32x4 b0 = *(const f32x4*)(bp + e * 8), b1 = *(const f32x4*)(bp + e * 8 + 4);
          float y[8];
#pragma unroll
          for (int q = 0; q < 4; ++q) {
            const float a = bflo(rw[q]), b = bfhi(rw[q]);
            const float ga = q < 2 ? g0[2 * q] : g1[2 * q - 4], gb = q < 2 ? g0[2 * q + 1] : g1[2 * q - 3];
            const float ba = q < 2 ? b0[2 * q] : b1[2 * q - 4], bb2 = q < 2 ? b0[2 * q + 1] : b1[2 * q - 3];
            y[2 * q] = (a - mean) * rstd * ga + ba;
            y[2 * q + 1] = (b - mean) * rstd * gb + bb2;
          }
          if (samp) {
            *(f32x4*)(so + e * 8) = (f32x4){y[0], y[1], y[2], y[3]};
            *(f32x4*)(so + e * 8 + 4) = (f32x4){y[4], y[5], y[6], y[7]};
          }
#pragma unroll
          for (int q = 0; q < 4; ++q) {
            const unsigned pk = cvt_pk_bf16(y[2 * q], y[2 * q + 1]);
            const int d = qtr * 128 + e * 8 + 2 * q;
            vnT[(size_t)d * 136 + row] = (bf16_t)(pk & 0xffffu);
            vnT[(size_t)(d + 1) * 136 + row] = (bf16_t)(pk >> 16);
          }
        }
      }
    }
    __syncthreads();
    if (!samp || w < 2) {
      const int tl = lane & 15, kg = lane >> 4;
      const int t = 16 * w + tl;
      const int r = rbase + t;
      for (int g = 0; g < 4; ++g) {
        f32x4 acc[8];
#pragma unroll
        for (int db = 0; db < 8; ++db) acc[db] = (f32x4){0.f, 0.f, 0.f, 0.f};
#pragma unroll
        for (int ks = 0; ks < 4; ++ks) {
          if (ks * 32 <= 16 * w + 15) {
            const bf16x8 wf = *(const bf16x8*)(WSM + ((size_t)g * 128 + t) * 128 + ks * 32 + kg * 8);
#pragma unroll
            for (int db = 0; db < 8; ++db) {
              const bf16x8 vf = *(const bf16x8*)(vnT + (size_t)(g * 128 + db * 16 + tl) * 136 + ks * 32 + kg * 8);
              acc[db] = __builtin_amdgcn_mfma_f32_16x16x32_bf16(vf, wf, acc[db], 0, 0, 0);
            }
          }
        }
        const float bias = kp->b_s[(l * 4 + g) * 128 + t];
#pragma unroll
        for (int db = 0; db < 8; ++db) {
          bf16_t* up = U + (size_t)r * 512 + g * 128 + db * 16 + kg * 4;
          const u32x2 uw = *(const u32x2*)up;
          u32x2 ow;
          ow[0] = cvt_pk_bf16(bflo(uw[0]) * (acc[db][0] + bias), bfhi(uw[0]) * (acc[db][1] + bias));
          ow[1] = cvt_pk_bf16(bflo(uw[1]) * (acc[db][2] + bias), bfhi(uw[1]) * (acc[db][3] + bias));
          *(u32x2*)up = ow;
        }
      }
    }
    __syncthreads();
  }
}

__device__ __forceinline__ int mbcnt64(unsigned long long m) { return __builtin_amdgcn_mbcnt_hi((unsigned)(m >> 32), __builtin_amdgcn_mbcnt_lo((unsigned)m, 0u)); }

template <int NB>
__device__ __forceinline__ void bisect256(const unsigned (&x)[64], unsigned& tau_out, int& cge_out) {
  unsigned tau = 0u;
  int cge = 0;
  for (int bit = 31; bit >= 0; --bit) {
    const unsigned cand = tau | (1u << bit);
    unsigned cl = 0u;
#pragma unroll
    for (int blk = 0; blk < NB; ++blk) {
      unsigned long long m0, m1, m2, m3, m4, m5, m6, m7;
      asm volatile(
          "v_cmp_ge_u32_e64 %1, %9, %17\n\tv_cmp_ge_u32_e64 %2, %10, %17\n\tv_cmp_ge_u32_e64 %3, %11, %17\n\tv_cmp_ge_u32_e64 %4, %12, %17\n\t"
          "v_cmp_ge_u32_e64 %5, %13, %17\n\tv_cmp_ge_u32_e64 %6, %14, %17\n\tv_cmp_ge_u32_e64 %7, %15, %17\n\tv_cmp_ge_u32_e64 %8, %16, %17\n\t"
          "v_addc_co_u32_e64 %0, %1, 0, %0, %1\n\tv_addc_co_u32_e64 %0, %2, 0, %0, %2\n\tv_addc_co_u32_e64 %0, %3, 0, %0, %3\n\t"
          "v_addc_co_u32_e64 %0, %4, 0, %0, %4\n\tv_addc_co_u32_e64 %0, %5, 0, %0, %5\n\tv_addc_co_u32_e64 %0, %6, 0, %0, %6\n\t"
          "v_addc_co_u32_e64 %0, %7, 0, %0, %7\n\tv_addc_co_u32_e64 %0, %8, 0, %0, %8"
          : "+v"(cl), "=&s"(m0), "=&s"(m1), "=&s"(m2), "=&s"(m3), "=&s"(m4), "=&s"(m5), "=&s"(m6), "=&s"(m7)
          : "v"(x[blk * 8 + 0]), "v"(x[blk * 8 + 1]), "v"(x[blk * 8 + 2]), "v"(x[blk * 8 + 3]), "v"(x[blk * 8 + 4]), "v"(x[blk * 8 + 5]),
            "v"(x[blk * 8 + 6]), "v"(x[blk * 8 + 7]), "v"(cand));
    }
    cl += (unsigned)__builtin_amdgcn_update_dpp(0, (int)cl, 0x111, 0xf, 0xf, true);
    cl += (unsigned)__builtin_amdgcn_update_dpp(0, (int)cl, 0x112, 0xf, 0xf, true);
    cl += (unsigned)__builtin_amdgcn_update_dpp(0, (int)cl, 0x114, 0xf, 0xf, true);
    cl += (unsigned)__builtin_amdgcn_update_dpp(0, (int)cl, 0x118, 0xf, 0xf, true);
    const int cnt = __builtin_amdgcn_readlane((int)cl, 15) + __builtin_amdgcn_readlane((int)cl, 31) + __builtin_amdgcn_readlane((int)cl, 47) +
                    __builtin_amdgcn_readlane((int)cl, 63);
    if (cnt >= 256) { tau = cand; cge = cnt; }
    if (cnt == 256) break;
  }
  tau_out = tau;
  cge_out = cge;
}

struct SelPre { bf16x8 af[4]; f32x4 wv[4]; bf16x8 b0[4][4]; };
__device__ __forceinline__ void sel_prefetch(SelPre& p, unsigned char* ws, int r0, const bf16_t* __restrict__ kib, int n, int w, int lane) {
  if (n <= 256) return;
  const int i = lane & 31, kg = lane >> 5;
  const bf16_t* qrow = (const bf16_t*)(ws + W_QI) + (size_t)(r0 + (i >> 2)) * 256 + (i & 3) * 64 + kg * 8;
#pragma unroll
  for (int ks = 0; ks < 4; ++ks) p.af[ks] = *(const bf16x8*)(qrow + ks * 16);
#pragma unroll
  for (int jj = 0; jj < 4; ++jj) p.wv[jj] = *(const f32x4*)((const float*)(ws + W_WI) + (size_t)(r0 + 2 * jj + kg) * 4);
}
__device__ __forceinline__ void sel_prefetch_keys(SelPre& p, const bf16_t* __restrict__ kib, int n, int w, int lane) {
  if (n <= 256) return;
  const int nkb = n >> 5;
#pragma unroll
  for (int u = 0; u < 4; ++u) {
    const int kbu = w + 8 * u < nkb ? w + 8 * u : w;
    const bf16_t* krow = kib + (size_t)kbu * 2048 + lane * 8;
#pragma unroll
    for (int ks = 0; ks < 4; ++ks) p.b0[u][ks] = *(const bf16x8*)(krow + ks * 512);
  }
}
__device__ __forceinline__ void select_group(unsigned char* ws, int r0, const bf16_t* __restrict__ kib, int n, float* sc, SelPre& pre, int nr0, const bf16_t* __restrict__ nkib, int nn) {
  const int tid = otid(), lane = tid & 63, w = tid >> 6;
  unsigned short* SEL = (unsigned short*)(ws + W_SEL);
  if (n <= 256) {
    unsigned short* selrow = SEL + (size_t)(r0 + w) * 256;
    for (int i = lane; i < n; i += 64) selrow[i] = (unsigned short)i;
    if (nn > 0) { sel_prefetch(pre, ws, nr0, nkib, nn, w, lane); sel_prefetch_keys(pre, nkib, nn, w, lane); }
    return;
  }
  {
    const int i = lane & 31, kg = lane >> 5;
    bf16x8 af[4];
    f32x4 wv[4];
#pragma unroll
    for (int ks = 0; ks < 4; ++ks) af[ks] = pre.af[ks];
#pragma unroll
    for (int jj = 0; jj < 4; ++jj) wv[jj] = pre.wv[jj];
    const int nkb = n >> 5;
    for (int kb0 = w; kb0 < nkb; kb0 += 32) {
      bf16x8 bfr[4][4];
      if (kb0 == w) {
#pragma unroll
        for (int u = 0; u < 4; ++u)
#pragma unroll
          for (int ks = 0; ks < 4; ++ks) bfr[u][ks] = pre.b0[u][ks];
      } else {
#pragma unroll
        for (int u = 0; u < 4; ++u) {
          const int kbu = kb0 + 8 * u < nkb ? kb0 + 8 * u : kb0;
          const bf16_t* krow = kib + (size_t)kbu * 2048 + lane * 8;
#pragma unroll
          for (int ks = 0; ks < 4; ++ks) bfr[u][ks] = *(const bf16x8*)(krow + ks * 512);
        }
      }
#pragma unroll
      for (int u = 0; u < 4; ++u) {
        if (kb0 + 8 * u < nkb) {
          const int key = (kb0 + 8 * u) * 32 + i;
          f32x16 acc;
#pragma unroll
          for (int e = 0; e < 16; ++e) acc[e] = 0.f;
#pragma unroll
          for (int ks = 0; ks < 4; ++ks) acc = __builtin_amdgcn_mfma_f32_32x32x16_bf16(af[ks], bfr[u][ks], acc, 0, 0, 0);
#pragma unroll
          for (int jj = 0; jj < 4; ++jj) {
            float sco = wv[jj][0] * fmaxf(acc[4 * jj], 0.f) + wv[jj][1] * fmaxf(acc[4 * jj + 1], 0.f) + wv[jj][2] * fmaxf(acc[4 * jj + 2], 0.f) +
                        wv[jj][3] * fmaxf(acc[4 * jj + 3], 0.f);
            sco += 0.0f;
            sc[(2 * jj + kg) * 4096 + key] = sco;
          }
        }
      }
    }
  }
  __syncthreads();
  if (nn > 0) sel_prefetch_keys(pre, nkib, nn, w, lane);
  {
    const float* rowl = sc + w * 4096 + lane;
    const int nreg = (n + 63) >> 6;
    const int nl = n - lane;
    unsigned x[64];
#pragma unroll
    for (int i = 0; i < 64; ++i) {
      const unsigned ub = __float_as_uint(rowl[i * 64]);
      const unsigned o = ub ^ ((unsigned)((int)ub >> 31) | 0x80000000u);
      x[i] = (i * 64 < nl) ? o : 0u;
    }
    unsigned tau = 0u;
    int cge = 0;
    switch ((nreg + 7) >> 3) {
      case 1: bisect256<1>(x, tau, cge); break;
      case 2: bisect256<2>(x, tau, cge); break;
      case 3: bisect256<3>(x, tau, cge); break;
      case 4: bisect256<4>(x, tau, cge); break;
      case 5: bisect256<5>(x, tau, cge); break;
      case 6: bisect256<6>(x, tau, cge); break;
      case 7: bisect256<7>(x, tau, cge); break;
      default: bisect256<8>(x, tau, cge); break;
    }
    unsigned tau2 = (unsigned)__builtin_amdgcn_readfirstlane((int)tau);
    asm volatile("" : "+s"(tau2));
    unsigned short* selrow = SEL + (size_t)(r0 + w) * 256;
    if (__builtin_amdgcn_readfirstlane(cge) == 256) {
      int myc = 0;
#pragma unroll
      for (int i = 0; i < 64; ++i) myc += (x[i] >= tau2) ? 1 : 0;
      int incl = myc;
#pragma unroll
      for (int d = 1; d < 64; d <<= 1) {
        const int t = __shfl_up(incl, d);
        incl += (lane >= d) ? t : 0;
      }
      int pos = incl - myc;
#pragma unroll
      for (int blk = 0; blk < 8; ++blk) {
        if (blk * 8 < nreg) {
#pragma unroll
          for (int i = blk * 8; i < blk * 8 + 8; ++i) {
            if (x[i] >= tau2) { selrow[pos] = (unsigned short)(i * 64 + lane); ++pos; }
          }
        }
      }
    } else {
      int cgt = 0;
#pragma unroll
      for (int blk = 0; blk < 8; ++blk) {
#pragma unroll
        for (int i = blk * 8; i < blk * 8 + 8; ++i) cgt += __popcll(__ballot(x[i] > tau2));
        __builtin_amdgcn_sched_barrier(0);
      }
      const int rem = 256 - cgt;
      int base = 0, taken = 0;
      unsigned tau3 = tau2;
      asm volatile("" : "+s"(tau3));
#pragma unroll
      for (int blk = 0; blk < 8; ++blk) {
        if (blk * 8 < nreg) {
#pragma unroll
          for (int i = blk * 8; i < blk * 8 + 8; ++i) {
            const bool gt = x[i] > tau3, eq = x[i] == tau3;
            const unsigned long long meq = __ballot(eq);
            const bool take = gt || (eq && (taken + mbcnt64(meq) < rem));
            const unsigned long long msel = __ballot(take);
            const int ps = base + mbcnt64(msel);
            if (take && ps < 256) selrow[ps] = (unsigned short)(i * 64 + lane);
            base += __popcll(msel);
            taken += __popcll(meq);
            __builtin_amdgcn_sched_barrier(0);
          }
        }
      }
    }
  }
  if (nn > 0) sel_prefetch(pre, ws, nr0, nkib, nn, w, lane);
  __syncthreads();
}

__device__ __forceinline__ void sel_params(unsigned char* ws, int l, int tile, int it, int& r0, const bf16_t*& kib, int& n) {
  if (tile < 256) {
    const int b = tile >> 5, cp = tile & 31, c = (it & 8) ? 63 - cp : cp;
    kib = (const bf16_t*)(ws + W_KIP) + (size_t)b * 4096 * 64;
    r0 = b * 4096 + c * 64 + (it & 7) * 8;
    n = 64 * (c + 1);
  } else {
    const int sb = tile - 256;
    kib = (const bf16_t*)(ws + W_KIS) + (size_t)(l * 16 + sb) * 2080 * 64;
    r0 = MP + sb * 32 + it * 8;
    n = 2080;
  }
}
__device__ __forceinline__ void phase_select(KP kp, int l, unsigned char* shm) {
  kp = launder(kp);
  float* sc = (float*)shm;
  unsigned char* ws = kp->ws;
  const int tid = otid(), lane = tid & 63, w = tid >> 6;
  for (int tile0 = blockIdx.x; tile0 < 272; tile0 += gridDim.x) {
    const int tile = tile0 < 256 ? (tile0 & 7) * 32 + (tile0 >> 3) : tile0;
    const int ng = tile >= 256 ? 4 : 16;
    SelPre pre;
    {
      int r0, n; const bf16_t* kib;
      sel_params(ws, l, tile, 0, r0, kib, n);
      sel_prefetch(pre, ws, r0, kib, n, w, lane);
      sel_prefetch_keys(pre, kib, n, w, lane);
    }
    for (int it = 0; it < ng; ++it) {
      int r0, n, nr0 = 0, nn = 0;
      const bf16_t *kib, *nkib = nullptr;
      sel_params(ws, l, tile, it, r0, kib, n);
      if (it + 1 < ng) sel_params(ws, l, tile, it + 1, nr0, nkib, nn);
      select_group(ws, r0, kib, n, sc, pre, nr0, nkib, nn);
    }
  }
}

__device__ __forceinline__ void phase_attn(KP kp, int l, unsigned char* shm) {
  kp = launder(kp);
  const int tid = otid(), lane = tid & 63, w = __builtin_amdgcn_readfirstlane(tid >> 6);
  unsigned char* ws = kp->ws;
  unsigned char* tileb = shm + w * 5120;
  unsigned short* selw = (unsigned short*)(shm + w * 5120 + 4608);
  const unsigned tr_addr = (unsigned)(size_t)tileb + (unsigned)((4 * (lane >> 4) + ((lane & 15) >> 2)) * 144 + (lane & 3) * 8);
  bf16_t* Q = (bf16_t*)(ws + W_Q);
  const unsigned short* SEL = (const unsigned short*)(ws + W_SEL);
  const int nn = lane & 15, kg = lane >> 4;
  const int ks8 = lane >> 3, dc = lane & 7;
  for (int q = blockIdx.x * 8 + w; q < MT; q += gridDim.x * 8) {
    int r = q;
    if (gridDim.x == 256 && q < MP) r = ((q >> 3) & 7) * 4096 + (q >> 11) * 256 + ((q >> 6) & 31) * 8 + (q & 7);
    const bf16_t *kbase, *vbase;
    int n;
    if (r < MP) {
      const int b = r >> 12, t = r & 4095;
      kbase = (const bf16_t*)(ws + W_KP) + (size_t)b * 4096 * 128;
      vbase = (const bf16_t*)(ws + W_VP) + (size_t)b * 4096 * 128;
      n = ((t >> 6) + 1) * 64;
    } else {
      const int sb = (r - MP) >> 5;
      kbase = (const bf16_t*)(ws + W_KS) + (size_t)(l * 16 + sb) * 2080 * 128;
      vbase = (const bf16_t*)(ws + W_VS) + (size_t)(l * 16 + sb) * 2080 * 128;
      n = 2080;
    }
    const int cnt = n < 256 ? n : 256;
    {
      u32x2 sv = *(const u32x2*)(SEL + (size_t)r * 256 + lane * 4);
      const int k0 = lane * 4;
      unsigned a0 = sv[0] & 0xffffu, a1 = sv[0] >> 16, a2 = sv[1] & 0xffffu, a3 = sv[1] >> 16;
      a0 = (k0 < cnt) ? a0 : 0u; a1 = (k0 + 1 < cnt) ? a1 : 0u; a2 = (k0 + 2 < cnt) ? a2 : 0u; a3 = (k0 + 3 < cnt) ? a3 : 0u;
      u32x2 o;
      o[0] = a0 | (a1 << 16); o[1] = a2 | (a3 << 16);
      *(u32x2*)(selw + lane * 4) = o;
    }
    __builtin_amdgcn_wave_barrier();
    bf16x8 kpre[8][2];
#pragma unroll
    for (int kvh = 0; kvh < 2; ++kvh) {
      bf16x8 bq0, bq1;
#pragma unroll
      for (int e = 0; e < 8; ++e) { bq0[e] = 0; bq1[e] = 0; }
      if (nn < 4) {
        const bf16_t* qp = Q + (size_t)r * 512 + (kvh * 4 + nn) * 64 + kg * 8;
        bq0 = *(const bf16x8*)qp;
        bq1 = *(const bf16x8*)(qp + 32);
      }
      f32x4 lg[16];
      for (int repQ = 0; repQ < ((PROBE & 128) ? 2 : 1); ++repQ)
      {
#pragma unroll
        for (int hb = 0; hb < 2; ++hb) {
          bf16x8 ka[8][2];
          if (kvh == 1 && hb == 0) {
#pragma unroll
            for (int k8 = 0; k8 < 8; ++k8) { ka[k8][0] = kpre[k8][0]; ka[k8][1] = kpre[k8][1]; }
          } else {
#pragma unroll
            for (int k8 = 0; k8 < 8; ++k8) {
              const int idx = selw[(hb * 8 + k8) * 16 + nn];
              const bf16_t* kp = kbase + (size_t)idx * 128 + kvh * 64 + kg * 8;
              ka[k8][0] = *(const bf16x8*)kp;
              ka[k8][1] = *(const bf16x8*)(kp + 32);
            }
          }
          __builtin_amdgcn_sched_barrier(0);
#pragma unroll
          for (int k8 = 0; k8 < 8; ++k8) {
            f32x4 a = (f32x4){0.f, 0.f, 0.f, 0.f};
            a = __builtin_amdgcn_mfma_f32_16x16x32_bf16(ka[k8][0], bq0, a, 0, 0, 0);
            a = __builtin_amdgcn_mfma_f32_16x16x32_bf16(ka[k8][1], bq1, a, 0, 0, 0);
            lg[hb * 8 + k8] = a;
          }
          __builtin_amdgcn_sched_barrier(0);
        }
      }
      u32x4 vr[32];
#pragma unroll
      for (int i = 0; i < 16; ++i) {
        const int idx = selw[i * 8 + ks8];
        vr[i] = *(const u32x4*)(vbase + (size_t)idx * 128 + kvh * 64 + dc * 8);
      }
      float mx = -1e30f;
#pragma unroll
      for (int kb = 0; kb < 16; ++kb)
#pragma unroll
        for (int j = 0; j < 4; ++j) {
          const int key = kb * 16 + kg * 4 + j;
          lg[kb][j] = key < cnt ? lg[kb][j] : -1e30f;
          mx = fmaxf(mx, lg[kb][j]);
        }
      mx = fmaxf(mx, __shfl_xor(mx, 16));
      mx = fmaxf(mx, __shfl_xor(mx, 32));
      float sum = 0.f;
#pragma unroll
      for (int kb = 0; kb < 16; ++kb)
#pragma unroll
        for (int j = 0; j < 4; ++j) { lg[kb][j] = __expf(lg[kb][j] - mx); sum += lg[kb][j]; }
      sum += __shfl_xor(sum, 16);
      sum += __shfl_xor(sum, 32);
      const float inv = 1.f / sum;
      bf16x8 pf[8];
#pragma unroll
      for (int s8 = 0; s8 < 8; ++s8) {
        u32x4 pk;
        pk[0] = cvt_pk_bf16(lg[2 * s8][0], lg[2 * s8][1]);
        pk[1] = cvt_pk_bf16(lg[2 * s8][2], lg[2 * s8][3]);
        pk[2] = cvt_pk_bf16(lg[2 * s8 + 1][0], lg[2 * s8 + 1][1]);
        pk[3] = cvt_pk_bf16(lg[2 * s8 + 1][2], lg[2 * s8 + 1][3]);
        pf[s8] = __builtin_bit_cast(bf16x8, pk);
      }
      f32x4 oacc[4];
#pragma unroll
      for (int c = 0; c < 4; ++c) oacc[c] = (f32x4){0.f, 0.f, 0.f, 0.f};
      for (int repV = 0; repV < ((PROBE & 256) ? 2 : 1); ++repV)
      {
        if (repV) {
#pragma unroll
          for (int c = 0; c < 4; ++c) oacc[c] = (f32x4){0.f, 0.f, 0.f, 0.f};
        }
#pragma unroll
        for (int i = 16; i < 32; ++i) {
          const int idx = selw[i * 8 + ks8];
          vr[i] = *(const u32x4*)(vbase + (size_t)idx * 128 + kvh * 64 + dc * 8);
        }
#pragma unroll
        for (int s8 = 0; s8 < 8; ++s8) {
#pragma unroll
          for (int it = 0; it < 4; ++it) *(u32x4*)(tileb + (it * 8 + ks8) * 144 + dc * 16) = vr[s8 * 4 + it];
          u32x2 t0, t1, t2, t3, t4, t5, t6, t7;
          asm volatile(
              "ds_read_b64_tr_b16 %0, %8\n\tds_read_b64_tr_b16 %1, %8 offset:2304\n\t"
              "ds_read_b64_tr_b16 %2, %8 offset:32\n\tds_read_b64_tr_b16 %3, %8 offset:2336\n\t"
              "ds_read_b64_tr_b16 %4, %8 offset:64\n\tds_read_b64_tr_b16 %5, %8 offset:2368\n\t"
              "ds_read_b64_tr_b16 %6, %8 offset:96\n\tds_read_b64_tr_b16 %7, %8 offset:2400\n\t"
              "s_waitcnt lgkmcnt(0)"
              : "=&v"(t0), "=&v"(t1), "=&v"(t2), "=&v"(t3), "=&v"(t4), "=&v"(t5), "=&v"(t6), "=&v"(t7)
              : "v"(tr_addr)
              : "memory");
          const bf16x8 a0 = __builtin_bit_cast(bf16x8, (u32x4){t0[0], t0[1], t1[0], t1[1]});
          const bf16x8 a1 = __builtin_bit_cast(bf16x8, (u32x4){t2[0], t2[1], t3[0], t3[1]});
          const bf16x8 a2 = __builtin_bit_cast(bf16x8, (u32x4){t4[0], t4[1], t5[0], t5[1]});
          const bf16x8 a3 = __builtin_bit_cast(bf16x8, (u32x4){t6[0], t6[1], t7[0], t7[1]});
          oacc[0] = __builtin_amdgcn_mfma_f32_16x16x32_bf16(a0, pf[s8], oacc[0], 0, 0, 0);
          oacc[1] = __builtin_amdgcn_mfma_f32_16x16x32_bf16(a1, pf[s8], oacc[1], 0, 0, 0);
          oacc[2] = __builtin_amdgcn_mfma_f32_16x16x32_bf16(a2, pf[s8], oacc[2], 0, 0, 0);
          oacc[3] = __builtin_amdgcn_mfma_f32_16x16x32_bf16(a3, pf[s8], oacc[3], 0, 0, 0);
          if (kvh == 0 && s8 == 3) {
#pragma unroll
            for (int k8 = 0; k8 < 8; ++k8) {
              const int idx = selw[k8 * 16 + nn];
              const bf16_t* kp = kbase + (size_t)idx * 128 + 64 + kg * 8;
              kpre[k8][0] = *(const bf16x8*)kp;
              kpre[k8][1] = *(const bf16x8*)(kp + 32);
            }
          }
        }
        __builtin_amdgcn_sched_barrier(0);
      }
      if (nn < 4) {
#pragma unroll
        for (int c = 0; c < 4; ++c) {
          u32x2 ow;
          ow[0] = cvt_pk_bf16(oacc[c][0] * inv, oacc[c][1] * inv);
          ow[1] = cvt_pk_bf16(oacc[c][2] * inv, oacc[c][3] * inv);
          *(u32x2*)((bf16_t*)(ws + W_OA) + (size_t)r * 512 + (kvh * 4 + nn) * 64 + 16 * c + 4 * kg) = ow;
        }
      }
      __builtin_amdgcn_wave_barrier();
    }
  }
}

__device__ __forceinline__ void phase_ln(float* R, const float* __restrict__ g, const float* __restrict__ b, bf16_t* xbf, float samp_scale, const float* __restrict__ part, int nsplit, bool f32_all) {
  const int tid = otid(), lane = tid & 63, gw = blockIdx.x * 8 + (tid >> 6), nw = gridDim.x * 8;
  f32x4 gv[4], bv[4];
#pragma unroll
  for (int i = 0; i < 4; ++i) { gv[i] = *(const f32x4*)(g + i * 256 + lane * 4); bv[i] = *(const f32x4*)(b + i * 256 + lane * 4); }
  for (int r = gw; r < MT; r += nw) {
    float* row = R + (size_t)r * 1024;
    f32x4 v[4];
#pragma unroll
    for (int i = 0; i < 4; ++i) v[i] = *(const f32x4*)(row + i * 256 + lane * 4);
    if (r >= MP) {
      for (int sp = 0; sp < nsplit; ++sp) {
        const float* prow = part + ((size_t)sp * MS + (r - MP)) * 1024;
#pragma unroll
        for (int i = 0; i < 4; ++i) v[i] = v[i] + *(const f32x4*)(prow + i * 256 + lane * 4);
      }
    }
    float s = 0.f;
#pragma unroll
    for (int i = 0; i < 4; ++i) s += v[i][0] + v[i][1] + v[i][2] + v[i][3];
#pragma unroll
    for (int o = 32; o >= 1; o >>= 1) s += __shfl_xor(s, o);
    const float mean = s * (1.f / 1024.f);
    float ss = 0.f;
#pragma unroll
    for (int i = 0; i < 4; ++i) { v[i] = v[i] - mean; ss += v[i][0] * v[i][0] + v[i][1] * v[i][1] + v[i][2] * v[i][2] + v[i][3] * v[i][3]; }
#pragma unroll
    for (int o = 32; o >= 1; o >>= 1) ss += __shfl_xor(ss, o);
    const float rstd = rsqrtf(ss * (1.f / 1024.f) + LN_EPS);
#pragma unroll
    for (int i = 0; i < 4; ++i) {
      const f32x4 y = v[i] * rstd * gv[i] + bv[i];
      if (r >= MP) *(f32x4*)(row + i * 256 + lane * 4) = y * samp_scale;
      else if (f32_all) *(f32x4*)(row + i * 256 + lane * 4) = y;
      if (xbf) {
        u32x2 wv;
        wv[0] = cvt_pk_bf16(y[0], y[1]); wv[1] = cvt_pk_bf16(y[2], y[3]);
        *(u32x2*)(xbf + (size_t)r * 1024 + i * 256 + lane * 4) = wv;
      }
    }
  }
}

__device__ __forceinline__ void tile32(const bf16_t* __restrict__ A, int lda, const bf16_t* __restrict__ Bt, int ldb, int K, int row0, int col0, int lane, f32x4 (&c)[2][2]) {
  const int i = lane & 15, kg = lane >> 4;
  const bf16_t* a0 = A + (size_t)(row0 + i) * lda + kg * 8;
  const bf16_t* a1 = a0 + (size_t)16 * lda;
  const bf16_t* b0 = Bt + (size_t)(col0 + i) * ldb + kg * 8;
  const bf16_t* b1 = b0 + (size_t)16 * ldb;
#pragma unroll 4
  for (int k = 0; k < K; k += 32) {
    const bf16x8 af0 = *(const bf16x8*)(a0 + k), af1 = *(const bf16x8*)(a1 + k), bf0 = *(const bf16x8*)(b0 + k), bf1 = *(const bf16x8*)(b1 + k);
    c[0][0] = __builtin_amdgcn_mfma_f32_16x16x32_bf16(af0, bf0, c[0][0], 0, 0, 0);
    c[0][1] = __builtin_amdgcn_mfma_f32_16x16x32_bf16(af0, bf1, c[0][1], 0, 0, 0);
    c[1][0] = __builtin_amdgcn_mfma_f32_16x16x32_bf16(af1, bf0, c[1][0], 0, 0, 0);
    c[1][1] = __builtin_amdgcn_mfma_f32_16x16x32_bf16(af1, bf1, c[1][1], 0, 0, 0);
  }
}
__device__ __forceinline__ void sample_proj(unsigned char* ws, int l) {
  const int tid = otid(), lane = tid & 63, gw = blockIdx.x * 8 + (tid >> 6), nw = gridDim.x * 8;
  const bf16_t* GA = (const bf16_t*)(ws + W_GA);
  const bf16_t* GB = (const bf16_t*)(ws + W_GB);
  bf16_t* MRG = (bf16_t*)(ws + W_MRG);
  for (int t = gw; t < 16 * 32; t += nw) {
    const int row0 = MP + (t >> 5) * 32, col0 = (t & 31) * 32;
    f32x4 ca[2][2], cb[2][2];
#pragma unroll
    for (int x = 0; x < 2; ++x)
#pragma unroll
      for (int y = 0; y < 2; ++y) { ca[x][y] = (f32x4){0.f, 0.f, 0.f, 0.f}; cb[x][y] = (f32x4){0.f, 0.f, 0.f, 0.f}; }
    tile32((const bf16_t*)(ws + W_OA), 512, (const bf16_t*)(ws + W_WPA) + (size_t)l * 1024 * 512, 512, 512, row0, col0, lane, ca);
    tile32((const bf16_t*)(ws + W_U), 512, (const bf16_t*)(ws + W_WPB) + (size_t)l * 1024 * 512, 512, 512, row0, col0, lane, cb);
#pragma unroll
    for (int rb = 0; rb < 2; ++rb)
#pragma unroll
      for (int cc = 0; cc < 2; ++cc)
#pragma unroll
        for (int j = 0; j < 4; ++j) {
          const size_t o = (size_t)(row0 + 16 * rb + (lane >> 4) * 4 + j) * 1024 + col0 + 16 * cc + (lane & 15);
          const float m = ((float)((const unsigned char*)GA)[o] * ca[rb][cc][j] + (float)((const unsigned char*)GB)[o] * cb[rb][cc][j]) * (1.f / 255.f);
          MRG[o] = (bf16_t)(cvt_pk_bf16(m, 0.f) & 0xffffu);
        }
  }
}
__device__ __forceinline__ void sample_ff1(unsigned char* ws, int l) {
  const int tid = otid(), lane = tid & 63, gw = blockIdx.x * 8 + (tid >> 6), nw = gridDim.x * 8;
  bf16_t* H = (bf16_t*)(ws + W_H);
  for (int t = gw; t < 16 * 128; t += nw) {
    const int row0 = MP + (t >> 7) * 32, col0 = (t & 127) * 32;
    f32x4 c[2][2];
#pragma unroll
    for (int x = 0; x < 2; ++x)
#pragma unroll
      for (int y = 0; y < 2; ++y) c[x][y] = (f32x4){0.f, 0.f, 0.f, 0.f};
    tile32((const bf16_t*)(ws + W_XBF), 1024, (const bf16_t*)(ws + W_FF1) + (size_t)l * 4096 * 1024, 1024, 1024, row0, col0, lane, c);
#pragma unroll
    for (int rb = 0; rb < 2; ++rb)
#pragma unroll
      for (int cc = 0; cc < 2; ++cc)
#pragma unroll
        for (int j = 0; j < 4; ++j) {
          const float a = fmaxf(c[rb][cc][j], 0.f);
          H[(size_t)(row0 + 16 * rb + (lane >> 4) * 4 + j) * LDH + col0 + 16 * cc + (lane & 15)] = (bf16_t)(cvt_pk_bf16(a * a, 0.f) & 0xffffu);
        }
  }
}

#define XB_TMO      128
#define XB_XCNT(j)  (256  + 64 * (j))
#define XB_XSUB(j)  (1280 + 64 * (j))
#define XB_XGEN(j)  (2304 + 64 * (j))
#define XB_TOP      3328
#define XB_TOPGEN   3392
#define XCD_BAR_WORDS 3456
#define XB_SPIN_CAP (1u << 18)
__device__ __forceinline__ unsigned xb_ld(unsigned* p) { return __hip_atomic_load(p, __ATOMIC_RELAXED, __HIP_MEMORY_SCOPE_AGENT); }
__device__ __forceinline__ unsigned xb_add(unsigned* p, unsigned v) { return __hip_atomic_fetch_add(p, v, __ATOMIC_RELAXED, __HIP_MEMORY_SCOPE_AGENT); }
__device__ __forceinline__ unsigned xb_xcc_id() { return (unsigned)__builtin_amdgcn_s_getreg((3 << 11) | 20) & 0xFu; }
#define XB_SPIN(cond, bar) do { unsigned _sp = 0; while (cond) { __builtin_amdgcn_s_sleep(1); \
    if ((++_sp & 255u) == 0u) { if (xb_ld(&(bar)[XB_TMO])) break; if (_sp > XB_SPIN_CAP) { atomicAdd(&(bar)[XB_TMO], 1u); break; } } } } while (0)
__device__ __forceinline__ void xcd_barrier_complete(unsigned* bar, unsigned x, unsigned& nloc, unsigned& nx) {
  const unsigned G = gridDim.x * gridDim.y * gridDim.z;
  unsigned sum, cnt, mine, sp = 0u;
  for (;;) {
    sum = 0u; cnt = 0u; mine = 0u;
#pragma unroll
    for (unsigned j = 0; j < 16; ++j) { const unsigned c = xb_ld(&bar[XB_XCNT(j)]); sum += c; cnt += (c > 0u) ? 1u : 0u; mine = (j == x) ? c : mine; }
    if (sum == G) break;
    __builtin_amdgcn_s_sleep(1);
    if ((++sp & 255u) == 0u) { if (xb_ld(&bar[XB_TMO])) break; if (sp > XB_SPIN_CAP) { atomicAdd(&bar[XB_TMO], 1u); break; } }
  }
  nloc = mine > 0u ? mine : 1u; nx = cnt > 0u ? cnt : 1u;
}
__device__ __forceinline__ void xcd_barrier(KP kp, volatile LAS unsigned* st) {
  asm volatile("s_waitcnt vmcnt(0)" ::: "memory");
  __syncthreads();
  if (threadIdx.x == 0) {
    unsigned* bar = (unsigned*)(launder(kp)->ws + W_BAR);
    const unsigned x = xb_xcc_id();
    __builtin_amdgcn_s_waitcnt(0);
    unsigned nloc = st[0], nx = st[1];
    if (nloc == 0u) { xcd_barrier_complete(bar, x, nloc, nx); st[0] = nloc; st[1] = nx; }
    const unsigned old = xb_add(&bar[XB_XSUB(x)], 1u);
    const unsigned gen = old / nloc;
    if (old + 1u == (gen + 1u) * nloc) {
      __builtin_amdgcn_fence(__ATOMIC_RELEASE, "agent");
      asm volatile("s_waitcnt vmcnt(0)" ::: "memory");
      const unsigned og = xb_add(&bar[XB_TOP], 1u);
      const unsigned tg = og / nx;
      if (og + 1u == (tg + 1u) * nx) xb_add(&bar[XB_TOPGEN], 1u);
      else XB_SPIN(xb_ld(&bar[XB_TOPGEN]) == tg, bar);
      __builtin_amdgcn_fence(__ATOMIC_ACQUIRE, "agent");
      xb_add(&bar[XB_XGEN(x)], 1u);
      asm volatile("s_waitcnt vmcnt(0)" ::: "memory");
    } else {
      XB_SPIN(xb_ld(&bar[XB_XGEN(x)]) == gen, bar);
      __builtin_amdgcn_fence(__ATOMIC_ACQUIRE, "agent");
      asm volatile("s_waitcnt vmcnt(0)" ::: "memory");
    }
  }
  __syncthreads();
}

#ifndef PH_MASK
#define PH_MASK 0xFFFF
#endif
__global__ void __launch_bounds__(512, 2) mega(Params p_unused) {
  extern __shared__ __attribute__((aligned(16))) unsigned char shm[];
  cg::grid_group grid = cg::this_grid();
  LAS unsigned char* lds = (LAS unsigned char*)shm;
  const KP kp0 = (KP)__builtin_amdgcn_kernarg_segment_ptr();
  volatile LAS unsigned* st = (volatile LAS unsigned*)(lds + 139264);
  if (threadIdx.x < 2) st[threadIdx.x] = 0u;
  __syncthreads();
  if (threadIdx.x == 0) (void)xb_add(&((unsigned*)(kp0->ws + W_BAR))[XB_XCNT(xb_xcc_id())], 1u);

  for (int rep = 0; rep < ((PROBE & 4) ? 2 : 1); ++rep)
  if (PH_MASK & 1) phase_prep(kp0, shm);
  if (kp0->ws == nullptr) grid.sync();
  xcd_barrier(kp0, st);
#pragma unroll 1
  for (int l = 0; l < 2; ++l) {
    for (int rep = 0; rep < ((PROBE & 1) ? 2 : 1); ++rep)
    if (PH_MASK & 2) {
      const KP kp = launder(kp0);
      unsigned char* ws = kp->ws;
      pg8::Gemm g{(bf16_t*)(ws + W_XBF), (const bf16_t*)(ws + W_WIN) + (size_t)l * NPK * 1024, MT, NPK, 1024, 1024, 1024, nullptr, nullptr};
      pg8::StaticOrder S;
      S.init(g.N, g.K, 1, gridDim.x, blockIdx.x);
      EpiIn E{l, kp->out, ws};
      pg8::gemm_phase(lds, g, S, E);
    }
    xcd_barrier(kp0, st);
    if (PH_MASK & 4) phase_fix(kp0, l, shm);
    xcd_barrier(kp0, st);
    for (int rep = 0; rep < ((PROBE & 2) ? 2 : 1); ++rep)
    if (PH_MASK & 8) phase_select(kp0, l, shm);
    xcd_barrier(kp0, st);
    for (int rep = 0; rep < ((PROBE & 32) ? 2 : 1); ++rep)
    if (PH_MASK & 16) phase_attn(kp0, l, shm);
    xcd_barrier(kp0, st);
    for (int rep = 0; rep < ((PROBE & 1024) ? 2 : 1); ++rep)
    if (PH_MASK & 32) {
      const KP kp = launder(kp0);
      unsigned char* ws = kp->ws;
      sample_proj(ws, l);
      pg8::StaticOrder S;
      S.init(1024, 512, 0, gridDim.x, blockIdx.x);
      {
        pg8::Gemm g{(const bf16_t*)(ws + W_OA), (const bf16_t*)(ws + W_WPA) + (size_t)l * 1024 * 512, MT, 1024, 512, 512, 512,
                    (const bf16_t*)(ws + W_U), (const bf16_t*)(ws + W_WPB) + (size_t)l * 1024 * 512};
        S.dual = 1;
        EpiGate E{(const unsigned char*)(ws + W_GA), (const unsigned char*)(ws + W_GB), (bf16_t*)(ws + W_MRG)};
        pg8::gemm_phase(lds, g, S, E);
      }
    }
    xcd_barrier(kp0, st);
    for (int rep = 0; rep < ((PROBE & 2048) ? 2 : 1); ++rep)
    if (PH_MASK & 64) {
      const KP kp = launder(kp0);
      unsigned char* ws = kp->ws;
      float* R = kp->out + O_Y;
      pg8::Gemm g{(bf16_t*)(ws + W_MRG), (const bf16_t*)(ws + W_WOUT) + (size_t)l * 1024 * 1024, MT, 1024, 1024, 1024, 1024, nullptr, nullptr};
      pg8::StaticOrder S;
      S.init(g.N, g.K, 4, gridDim.x, blockIdx.x);
      EpiRes E{l == 0 ? kp->x_prompt : nullptr, (const bf16_t*)(ws + W_XBF), R, (float*)(ws + W_PART)};
      pg8::gemm_phase(lds, g, S, E);
    }
    xcd_barrier(kp0, st);
    if (PH_MASK & 128) {
      const KP kp = launder(kp0);
      phase_ln(kp->out + O_Y, kp->ln1_g + l * 1024, kp->ln1_b + l * 1024, (bf16_t*)(kp->ws + W_XBF), ALPHA, (const float*)(kp->ws + W_PART), 4, false);
    }
    xcd_barrier(kp0, st);
    for (int rep = 0; rep < ((PROBE & 512) ? 2 : 1); ++rep)
    if (PH_MASK & 256) {
      const KP kp = launder(kp0);
      unsigned char* ws = kp->ws;
      sample_ff1(ws, l);
      pg8::Gemm g{(bf16_t*)(ws + W_XBF), (const bf16_t*)(ws + W_FF1) + (size_t)l * 4096 * 1024, MT, DFF, 1024, 1024, 1024, nullptr, nullptr};
      pg8::StaticOrder S;
      S.init(g.N, g.K, 0, gridDim.x, blockIdx.x);
      EpiFF1 E{(bf16_t*)(ws + W_H)};
      pg8::gemm_phase(lds, g, S, E);
    }
    xcd_barrier(kp0, st);
    for (int rep = 0; rep < ((PROBE & 4096) ? 2 : 1); ++rep)
    if (PH_MASK & 512) {
      const KP kp = launder(kp0);
      unsigned char* ws = kp->ws;
      float* R = kp->out + O_Y;
      pg8::Gemm g{(const bf16_t*)(ws + W_H), (const bf16_t*)(ws + W_FF2) + (size_t)l * 1024 * LDH, MT, 1024, 4096, LDH, LDH, nullptr, nullptr};
      pg8::StaticOrder S;
      S.init(g.N, g.K, 8, gridDim.x, blockIdx.x);
      EpiRes E{nullptr, (const bf16_t*)(ws + W_XBF), R, (float*)(ws + W_PART)};
      pg8::gemm_phase(lds, g, S, E);
    }
    xcd_barrier(kp0, st);
    if (PH_MASK & 1024) {
      const KP kp = launder(kp0);
      phase_ln(kp->out + O_Y, kp->ln2_g + l * 1024, kp->ln2_b + l * 1024, l == 0 ? (bf16_t*)(kp->ws + W_XBF) : nullptr, l == 0 ? ALPHA : 1.0f, (const float*)(kp->ws + W_PART), 8, l == 1);
    }
    xcd_barrier(kp0, st);
  }
  if (PROBE & 64) { for (int q = 0; q < 40; ++q) xcd_barrier(kp0, st); }
}

extern "C" void kernel_launch(void* const* d_in, const int* in_sizes, int n_in, void* d_out, int out_size, void* d_ws, size_t ws_size,
                              hipStream_t stream) {
  static int grid_blocks = 0;
  if (!grid_blocks) {
    int dev = 0, cus = 0, per_cu = 0;
    if (n_in != 21 || (size_t)out_size != O_END || ws_size < W_END) {
      fprintf(stderr, "kernel_launch: unexpected sizes n_in %d out %d ws %zu (need %zu)\n", n_in, out_size, ws_size, (size_t)W_END);
      grid_blocks = -1;
      return;
    }
    if (hipGetDevice(&dev) != hipSuccess || hipDeviceGetAttribute(&cus, hipDeviceAttributeMultiprocessorCount, dev) != hipSuccess) { grid_blocks = -1; return; }
    if (hipFuncSetAttribute((const void*)mega, hipFuncAttributeMaxDynamicSharedMemorySize, LDS_BYTES) != hipSuccess) { grid_blocks = -1; return; }
    if (hipOccupancyMaxActiveBlocksPerMultiprocessor(&per_cu, (const void*)mega, 512, LDS_BYTES) != hipSuccess || per_cu < 1) {
      fprintf(stderr, "kernel_launch: occupancy query says %d blocks/CU\n", per_cu);
      grid_blocks = -1;
      return;
    }
    grid_blocks = cus;
  }
  if (grid_blocks < 0) return;
  Params p{};
  const float** pp = (const float**)&p;
  for (int i = 0; i < 21; ++i) pp[i] = (const float*)d_in[i];
  p.out = (float*)d_out;
  p.ws = (unsigned char*)d_ws;
  if (hipMemsetAsync((unsigned char*)d_ws + W_BAR, 0, 16384, stream) != hipSuccess) { fprintf(stderr, "kernel_launch: memset of barrier words failed\n"); return; }
  void* args[] = {&p};
  hipError_t e = hipLaunchCooperativeKernel((void*)mega, dim3(grid_blocks), dim3(512), args, LDS_BYTES, stream);
  if (e != hipSuccess) fprintf(stderr, "cooperative launch failed: %s (grid %d)\n", hipGetErrorString(e), grid_blocks);
}
```

```cpp
#include <hip/hip_runtime.h>
#include <hip/hip_cooperative_groups.h>
#include <cstdio>
namespace cg = cooperative_groups;

#ifndef PROBE
#define PROBE 0
#endif
#define LAS __attribute__((address_space(3)))
typedef unsigned short bf16_t;
typedef short bf16x8 __attribute__((ext_vector_type(8)));
typedef float f32x4 __attribute__((ext_vector_type(4)));
typedef float f32x16 __attribute__((ext_vector_type(16)));
typedef unsigned u32x4 __attribute__((ext_vector_type(4)));
typedef unsigned u32x2 __attribute__((ext_vector_type(2)));

constexpr int MP = 32768, MS = 512, MT = 33280, DM = 1024, NPK = 4352, DFF = 4096;
constexpr int LDH = 4096 + 64;
constexpr float ALPHA = 1.41421356237f, LN_EPS = 1e-5f;
constexpr size_t O_Y = 0, O_PK = 34078720, O_PV = 42467328, O_PIK = 50855936, O_SK = 55050240, O_SV = 55181312, O_SIK = 55312384,
                 O_SSV = 55377920, O_END = 55902208;
constexpr size_t W_WIN = 0;
constexpr size_t W_WPA = W_WIN + 2ull * 4352 * 1024 * 2;
constexpr size_t W_WPB = W_WPA + 2ull * 1024 * 512 * 2;
constexpr size_t W_WOUT = W_WPB + 2ull * 1024 * 512 * 2;
constexpr size_t W_FF1 = W_WOUT + 2ull * 1024 * 1024 * 2;
constexpr size_t W_FF2 = W_FF1 + 2ull * 4096 * 1024 * 2;
constexpr size_t W_WSM = W_FF2 + 2ull * LDH * 1024 * 2;
constexpr size_t W_ROPE = W_WSM + 2ull * 4 * 128 * 128 * 2;
constexpr size_t W_XBF = W_ROPE + 4096ull * 16 * 4;
constexpr size_t W_BIG = W_XBF + (size_t)MT * 1024 * 2;
constexpr size_t W_Q = W_BIG;
constexpr size_t W_KP = W_Q + (size_t)MT * 512 * 2;
constexpr size_t W_VP = W_KP + (size_t)MP * 128 * 2;
constexpr size_t W_QI = W_VP + (size_t)MP * 128 * 2;
constexpr size_t W_KIP = W_QI + (size_t)MT * 256 * 2;
constexpr size_t W_KIRAW = W_KIP + (size_t)MP * 64 * 2;
constexpr size_t W_WI = W_KIRAW + (size_t)MT * 64 * 4;
constexpr size_t W_U = W_WI + (size_t)MT * 4 * 4;
constexpr size_t W_VG = W_U + (size_t)MT * 512 * 2;
constexpr size_t W_GA = W_VG + (size_t)MT * 512 * 2;
constexpr size_t W_GB = W_GA + (size_t)MT * 1024 * 2;
constexpr size_t W_BIGEND = W_GB + (size_t)MT * 1024 * 2;
constexpr size_t W_MRG = W_Q;
static_assert((size_t)MT * 1024 * 2 <= W_KIRAW - W_Q, "merged overlay");
constexpr size_t W_H = W_BIG;
static_assert((size_t)MT * LDH * 2 <= W_BIGEND - W_BIG, "H overlay");
constexpr size_t W_KS = W_BIGEND;
constexpr size_t W_VS = W_KS + 2ull * 16 * 2080 * 128 * 2;
constexpr size_t W_KIS = W_VS + 2ull * 16 * 2080 * 128 * 2;
constexpr size_t W_SEL = W_KIS + 2ull * 16 * 2080 * 64 * 2;
constexpr size_t W_OA = W_SEL + (size_t)MT * 256 * 2;
constexpr size_t W_PART = W_OA + (size_t)MT * 512 * 2;
constexpr size_t W_BAR = W_PART + 8ull * MS * 1024 * 4;
constexpr size_t W_END = W_BAR + 16384;

constexpr int LDS_BYTES = 139264 + 16;

struct Params {
  const float *x_prompt, *x_sample, *cache_k, *cache_v, *cache_ik, *w_in, *idx_g, *idx_b, *sgu_g, *sgu_b, *w_s, *b_s, *w_pa, *w_pb, *w_out,
      *ln1_g, *ln1_b, *w_ff1, *w_ff2, *ln2_g, *ln2_b;
  float* out;
  unsigned char* ws;
};

__device__ __forceinline__ unsigned cvt_pk_bf16(float lo, float hi) {
  unsigned r;
  asm volatile("v_cvt_pk_bf16_f32 %0, %1, %2" : "=v"(r) : "v"(lo), "v"(hi));
  return r;
}
template <class T> __device__ __forceinline__ T launder(T p) { asm volatile("" : "+s"(p)); return p; }
typedef const __attribute__((address_space(4))) Params* KP;
__device__ __forceinline__ int otid() { int t = threadIdx.x; asm volatile("" : "+v"(t)); return t; }
__device__ __forceinline__ float bflo(unsigned w) { return __uint_as_float(w << 16); }
__device__ __forceinline__ float bfhi(unsigned w) { return __uint_as_float(w & 0xffff0000u); }
__device__ __forceinline__ float bf2f(bf16_t b) { return __uint_as_float(((unsigned)b) << 16); }

__device__ __forceinline__ size_t kif_off(int key, int li  ) { return ((size_t)(((key >> 5) * 4 + (li >> 2)) * 64 + ((li >> 1) & 1) * 32 + (key & 31))) * 8 + (li & 1) * 4; }
enum { G_Q = 0, G_K, G_V, G_QI, G_KI, G_WI, G_U, G_VG, G_GA, G_GB, G_PAD };
__host__ __device__ __forceinline__ void slot_info(int S, int& grp, int& off) {
  if (S < 16) { grp = G_Q; off = 32 * S; }
  else if (S < 20) { grp = G_K; off = 32 * (S - 16); }
  else if (S < 24) { grp = G_V; off = 32 * (S - 20); }
  else if (S < 32) { grp = G_QI; off = 32 * (S - 24); }
  else if (S < 40) {
    if (S == 32) { grp = G_KI; off = 0; }
    else if (S == 33) { grp = G_WI; off = 0; }
    else if (S == 34) { grp = G_U; off = 0; }
    else if (S == 35) { grp = G_U; off = 32; }
    else if (S == 36) { grp = G_KI; off = 32; }
    else { grp = G_U; off = 32 * (S - 35); }
  }
  else if (S < 51) { grp = G_U; off = 32 * (S - 35); }
  else if (S < 67) { grp = G_VG; off = 32 * (S - 51); }
  else if (S < 99) { grp = G_GA; off = 32 * (S - 67); }
  else if (S < 131) { grp = G_GB; off = 32 * (S - 99); }
  else { grp = G_PAD; off = 0; }
}
__device__ __forceinline__ int win_orig_col(int p) {
  int grp, off;
  slot_info(p >> 5, grp, off);
  const int c = p & 31;
  switch (grp) {
    case G_Q: return off + c;
    case G_K: return 512 + off + c;
    case G_V: return 640 + off + c;
    case G_QI: return 768 + off + c;
    case G_KI: return 1024 + off + c;
    case G_WI: return c < 4 ? 1088 + c : -1;
    case G_U: return 1092 + off + c;
    case G_VG: return 1604 + off + c;
    case G_GA: return 2116 + off + c;
    case G_GB: return 3140 + off + c;
    default: return -1;
  }
}

namespace pg8 {
constexpr int BM = 256, BK = 64, HALF = 128, HTB = HALF * BK * 2, STAGE_BYTES = 8 * HTB, NXCD = 8, WGM = 8;
__host__ __device__ __forceinline__ int lds_byte(int r, int c) {
  const int st = (r >> 4) * 2 + (c >> 5), rr = r & 15, cc = c & 31, ob = rr * 64 + cc * 2;
  return st * 1024 + (ob ^ (((ob >> 9) & 1) << 5));
}
__host__ __device__ __forceinline__ void stage_rc(int b, int& R, int& C) {
  const int st = b / 1024, sb = b % 1024, swz = sb ^ (((sb >> 9) & 1) << 5);
  R = (st >> 1) * 16 + swz / 64;
  C = (st & 1) * 32 + (swz % 64) / 2;
}
__host__ __device__ __forceinline__ int perm32(int rho) { const int n = rho >> 4, i = rho & 15; return 8 * (i >> 2) + 4 * n + (i & 3); }
struct Unit { int pm, pn, kt0, nt, split, which; };
struct Gemm { const bf16_t* A; const bf16_t* Bt; int M, N, K, lda, ldb; const bf16_t* A2; const bf16_t* Bt2; };
struct StaticOrder {
  int nM, nN, nwg, nextra, splits, ntfull, G, c, dual;
  __device__ void init(int N, int K, int splits_, int G_, int c_) {
    nM = MP / BM; nN = N / BM; nwg = nM * nN; splits = splits_ > 0 ? splits_ : 1; nextra = 2 * nN * splits_; ntfull = K / BK; G = G_; c = c_; dual = 0;
  }
  __device__ bool next(int i, Unit& u) const {
    const long L = (long)(i >> dual) * G + c;
    u.which = dual ? (i & 1) : 0;
    if (L < nwg) {
      int wgid = (int)L;
      { const int q = nwg / NXCD, r = nwg % NXCD, xcd = wgid % NXCD, off = wgid / NXCD; wgid = (xcd < r ? xcd * (q + 1) : r * (q + 1) + (xcd - r) * q) + off; }
      const int nig = WGM * nN, gid = wgid / nig, fm = gid * WGM, gsz = (nM - fm) < WGM ? (nM - fm) : WGM;
      u.pm = fm + ((wgid % nig) % gsz);
      u.pn = (wgid % nig) / gsz;
      u.kt0 = 0; u.nt = ntfull; u.split = 0;
      return true;
    }
    const int j = (int)(L - nwg);
    if (j >= nextra) return false;
    const int per_panel = nN * splits;
    u.pm = nM + j / per_panel;
    const int rem = j % per_panel;
    u.pn = rem / splits;
    u.nt = ntfull / splits;
    u.kt0 = (rem % splits) * u.nt;
    u.split = splits > 1 ? 1 : 0;
    return true;
  }
};

template <class Epi>
__device__ __forceinline__ void gemm_phase(LAS unsigned char* lds, const Gemm g, const StaticOrder& S, const Epi& E) {
  const int tid = otid(), wid = __builtin_amdgcn_readfirstlane(tid >> 6), lane = tid & 63, wr = wid >> 2, wc = wid & 3, fr = lane & 15, fq = lane >> 4;
  const int K = g.K;
  unsigned voffA[2], voffB[2];
#pragma unroll
  for (int i = 0; i < 2; ++i) {
    int R, C;
    stage_rc(tid * 16 + i * 8192, R, C);
    const int Rb = Epi::PERM ? ((R & ~31) + perm32(R & 31)) : R;
    voffA[i] = (unsigned)(R * g.lda + C) * 2u;
    voffB[i] = (unsigned)(Rb * g.ldb + C) * 2u;
  }
  const size_t kstep = (size_t)(BK * 2);
  const size_t hstepA = (size_t)HALF * g.lda * 2, hstepB = (size_t)HALF * g.ldb * 2;
  const size_t tstepA = 2 * hstepA, tstepB = 2 * hstepB;
  const unsigned ldsw = (unsigned)wid * 1024u;
  const int aoff = lds_byte(wr * 64 + fr, fq * 8), boff = lds_byte(wc * 32 + fr, fq * 8);
#define PG8_SA(b, h) (((b) * 2 + (h)) * HTB)
#define PG8_SB(b, h) ((4 + (b) * 2 + (h)) * HTB)
#define PG8_STAGE(bufoff, gbase, voff) do { _Pragma("unroll") for (int _i = 0; _i < 2; ++_i) \
    __builtin_amdgcn_global_load_lds((const unsigned*)((const char*)(gbase) + (voff)[_i]), (LAS unsigned*)(lds + (bufoff) + ldsw + _i * 8192), 16, 0, 0); } while (0)
#define PG8_LDA(dst, b, h) do { _Pragma("unroll") for (int m = 0; m < 4; ++m) _Pragma("unroll") for (int k = 0; k < 2; ++k) dst[m][k] = *(const LAS bf16x8*)(lds + PG8_SA(b, h) + aoff + m * 2048 + k * 1024); } while (0)
#define PG8_LDB(dst, b, h) do { _Pragma("unroll") for (int n = 0; n < 2; ++n) _Pragma("unroll") for (int k = 0; k < 2; ++k) dst[n][k] = *(const LAS bf16x8*)(lds + PG8_SB(b, h) + boff + n * 2048 + k * 1024); } while (0)
#define PG8_MMA(ai, bj, At, Bt) do { __builtin_amdgcn_s_setprio(1); _Pragma("unroll") for (int m = 0; m < 4; ++m) _Pragma("unroll") for (int n = 0; n < 2; ++n) _Pragma("unroll") for (int k = 0; k < 2; ++k) \
    acc[ai][bj][m][n] = __builtin_amdgcn_mfma_f32_16x16x32_bf16(Bt[n][k], At[m][k], acc[ai][bj][m][n], 0, 0, 0); __builtin_amdgcn_s_setprio(0); } while (0)
#define PG8_WAIT_V(n) asm volatile("s_waitcnt vmcnt(" #n ")" ::: "memory")
#define PG8_WAIT_L(n) asm volatile("s_waitcnt lgkmcnt(" #n ")" ::: "memory")
#define PG8_BAR __builtin_amdgcn_s_barrier()
#define PG8_SCHED __builtin_amdgcn_sched_barrier(0)
  Unit cur, nxt;
  int ui = 0;
  if (!S.next(0, cur)) return;
  f32x4 acc[2][2][4][2];
#pragma unroll
  for (int a = 0; a < 2; ++a)
#pragma unroll
    for (int b = 0; b < 2; ++b)
#pragma unroll
      for (int m = 0; m < 4; ++m)
#pragma unroll
        for (int n = 0; n < 2; ++n) acc[a][b][m][n] = (f32x4){0.f, 0.f, 0.f, 0.f};
  bf16x8 At[4][2], B0[2][2], B1[2][2];
  const char* cA = (const char*)(cur.which ? g.A2 : g.A) + (size_t)cur.pm * tstepA + (size_t)cur.kt0 * kstep;
  const char* cB = (const char*)(cur.which ? g.Bt2 : g.Bt) + (size_t)cur.pn * tstepB + (size_t)cur.kt0 * kstep;
  PG8_STAGE(PG8_SB(0, 0), cB, voffB); PG8_STAGE(PG8_SA(0, 0), cA, voffA); PG8_STAGE(PG8_SB(0, 1), cB + hstepB, voffB); PG8_STAGE(PG8_SA(0, 1), cA + hstepA, voffA);
  if (wr == 1) PG8_BAR;
  PG8_WAIT_V(4); PG8_BAR;
  PG8_STAGE(PG8_SB(1, 0), cB + kstep, voffB); PG8_STAGE(PG8_SA(1, 0), cA + kstep, voffA); PG8_STAGE(PG8_SB(1, 1), cB + hstepB + kstep, voffB);
  PG8_WAIT_V(6); PG8_BAR;
  for (;;) {
    const bool has_next = S.next(ui + 1, nxt);
    const char* nA = has_next ? (const char*)(nxt.which ? g.A2 : g.A) + (size_t)nxt.pm * tstepA + (size_t)nxt.kt0 * kstep : cA;
    const char* nB = has_next ? (const char*)(nxt.which ? g.Bt2 : g.Bt) + (size_t)nxt.pn * tstepB + (size_t)nxt.kt0 * kstep : cB;
    const int nt = cur.nt;
    for (int t = 0; t < nt; t += 2) {
      const bool last = (t == nt - 2);
      const char* a1 = cA + (size_t)(t + 1) * kstep;
      const char* a2 = last ? nA : cA + (size_t)(t + 2) * kstep;
      const char* b2 = last ? nB : cB + (size_t)(t + 2) * kstep;
      const char* a3 = a2 + kstep;
      const char* b3 = b2 + kstep;
      PG8_LDB(B0, 0, 0); PG8_SCHED; PG8_LDA(At, 0, 0); PG8_STAGE(PG8_SA(1, 1), a1 + hstepA, voffA);
      PG8_WAIT_L(8); PG8_BAR; PG8_WAIT_L(0); PG8_MMA(0, 0, At, B0); PG8_BAR; PG8_SCHED;
      PG8_LDB(B1, 0, 1); PG8_STAGE(PG8_SB(0, 0), b2, voffB);
      PG8_BAR; PG8_WAIT_L(0); PG8_MMA(0, 1, At, B1); PG8_BAR;
      PG8_LDA(At, 0, 1); PG8_STAGE(PG8_SA(0, 0), a2, voffA);
      PG8_BAR; PG8_WAIT_L(0); PG8_MMA(1, 0, At, B0); PG8_BAR; PG8_SCHED;
      PG8_STAGE(PG8_SB(0, 1), b2 + hstepB, voffB);
      PG8_WAIT_V(6); PG8_BAR; PG8_MMA(1, 1, At, B1); PG8_BAR;
      PG8_LDB(B0, 1, 0); PG8_SCHED; PG8_LDA(At, 1, 0); PG8_STAGE(PG8_SA(0, 1), a2 + hstepA, voffA);
      PG8_WAIT_L(8); PG8_BAR; PG8_WAIT_L(0); PG8_MMA(0, 0, At, B0); PG8_BAR; PG8_SCHED;
      PG8_LDB(B1, 1, 1); PG8_STAGE(PG8_SB(1, 0), b3, voffB);
      PG8_BAR; PG8_WAIT_L(0); PG8_MMA(0, 1, At, B1); PG8_BAR;
      PG8_LDA(At, 1, 1); PG8_STAGE(PG8_SA(1, 0), a3, voffA);
      PG8_BAR; PG8_WAIT_L(0); PG8_MMA(1, 0, At, B0); PG8_BAR; PG8_SCHED;
      PG8_STAGE(PG8_SB(1, 1), b3 + hstepB, voffB);
      PG8_WAIT_V(6); PG8_BAR; PG8_MMA(1, 1, At, B1); PG8_BAR;
    }
    E(acc, cur, wr, wc, fr, fq);
    if (!has_next) break;
#pragma unroll
    for (int a = 0; a < 2; ++a)
#pragma unroll
      for (int b = 0; b < 2; ++b)
#pragma unroll
        for (int m = 0; m < 4; ++m)
#pragma unroll
          for (int n = 0; n < 2; ++n) acc[a][b][m][n] = (f32x4){0.f, 0.f, 0.f, 0.f};
    cur = nxt; cA = nA; cB = nB; ++ui;
  }
  PG8_WAIT_V(0);
  if (wr == 0) PG8_BAR;
  PG8_BAR;
#undef PG8_SA
#undef PG8_SB
#undef PG8_STAGE
#undef PG8_LDA
#undef PG8_LDB
#undef PG8_MMA
#undef PG8_WAIT_V
#undef PG8_WAIT_L
#undef PG8_BAR
#undef PG8_SCHED
}
}
using pg8::Unit;

struct EpiIn {
  static constexpr bool PERM = true;
  int l;
  float* out;
  unsigned char* ws;
  static __device__ __forceinline__ void rot_mul(f32x4 (&a)[4], const f32x4 (&b)[4]) {
#pragma unroll
    for (int e = 0; e < 4; ++e) {
      const f32x4 x = a[e], y = b[e];
      a[e] = (f32x4){x[0] * y[0] - x[1] * y[1], x[1] * y[0] + x[0] * y[1], x[2] * y[2] - x[3] * y[3], x[3] * y[2] + x[2] * y[3]};
    }
  }
  template <int CAT>
  __device__ __forceinline__ void slot(const f32x4 (&acc)[2][2][4][2], int bj, int r00, int p0, bool sunit, int fq, int c0, bf16_t* bdst, int bstride, float* fdst,
                                       float scale) const {
    const float* rope = (const float*)(ws + W_ROPE);
    const f32x4 r16[4] = {{-9.576594803e-01f, -2.879033167e-01f, -9.992462583e-01f, 3.881900626e-02f}, {8.243765167e-01f, 5.660418348e-01f, 9.932003015e-01f, 1.164180448e-01f}, {9.997440109e-01f, 2.262548617e-02f, 9.999903729e-01f, 4.387956933e-03f}, {9.999996380e-01f, 8.509272148e-04f, 9.999999864e-01f, 1.650141632e-04f}};
#pragma unroll
    for (int ai = 0; ai < 2; ++ai) {
      f32x4 csa[4];
      if (CAT == 0) {
        const int pa = sunit ? p0 : p0 + 128 * ai;
#pragma unroll
        for (int e = 0; e < 4; ++e) csa[e] = *(const f32x4*)(rope + (size_t)pa * 16 + e * 4);
      }
#pragma unroll
      for (int m = 0; m < 4; ++m) {
        const int r = r00 + ai * 128 + m * 16;
        const int sr = r - MP;
        float v[8];
#pragma unroll
        for (int e = 0; e < 4; ++e) {
          v[e] = bj == 0 ? acc[ai][0][m][0][e] : acc[ai][1][m][0][e];
          v[4 + e] = bj == 0 ? acc[ai][0][m][1][e] : acc[ai][1][m][1][e];
        }
        if (CAT == 0) {
          if (m == 2 && sunit) {
#pragma unroll
            for (int e = 0; e < 4; ++e) csa[e] = *(const f32x4*)(rope + (size_t)p0 * 16 + e * 4);
          }
          float pr[8];
#pragma unroll
          for (int e = 0; e < 8; ++e) pr[e] = __shfl_xor(v[e], 16);
          if (fq < 2) {
#pragma unroll
            for (int e2 = 0; e2 < 4; ++e2) {
              const f32x4 t = csa[e2];
              if (fq == 0) {
                v[2 * e2] = v[2 * e2] * t[0] - pr[2 * e2] * t[1];
                v[2 * e2 + 1] = v[2 * e2 + 1] * t[2] - pr[2 * e2 + 1] * t[3];
              } else {
                v[2 * e2] = pr[2 * e2] * t[1] + v[2 * e2] * t[0];
                v[2 * e2 + 1] = pr[2 * e2 + 1] * t[3] + v[2 * e2 + 1] * t[2];
              }
            }
          }
          if (m < 3) rot_mul(csa, r16);
        }
        if (CAT == 2) {
          unsigned q[8];
#pragma unroll
          for (int e = 0; e < 8; ++e) q[e] = (unsigned)(__frcp_rn(1.f + __expf(-v[e])) * 255.f + 0.5f);
          u32x2 w8;
          w8[0] = q[0] | (q[1] << 8) | (q[2] << 16) | (q[3] << 24);
          w8[1] = q[4] | (q[5] << 8) | (q[6] << 16) | (q[7] << 24);
          *(u32x2*)((unsigned char*)bdst + (size_t)r * 1024 + c0) = w8;
          continue;
        }
        if (CAT == 3) {
          float* d = (float*)(ws + W_KIRAW) + (size_t)r * 64 + c0;
          *(f32x4*)d = (f32x4){v[0], v[1], v[2], v[3]};
          *(f32x4*)(d + 4) = (f32x4){v[4], v[5], v[6], v[7]};
        } else if (CAT == 4) {
          if (fq == 0) *(f32x4*)((float*)(ws + W_WI) + (size_t)r * 4) = (f32x4){v[0] * 0.5f, v[1] * 0.5f, v[2] * 0.5f, v[3] * 0.5f};
        } else {
          u32x4 w;
#pragma unroll
          for (int e = 0; e < 4; ++e) w[e] = cvt_pk_bf16(v[2 * e] * scale, v[2 * e + 1] * scale);
          size_t brow = (size_t)r;
          if (fdst && sunit) brow = (size_t)(l * 16 + (sr >> 5)) * 2080 + 2048 + (sr & 31);
          *(u32x4*)(bdst + brow * bstride + c0) = w;
          if (fdst) {
            float* fp = fdst + ((size_t)(sunit ? l * MS + sr : l * MP + r)) * 128 + c0;
            *(f32x4*)fp = (f32x4){v[0], v[1], v[2], v[3]};
            *(f32x4*)(fp + 4) = (f32x4){v[4], v[5], v[6], v[7]};
          }
        }
        if (CAT == 0) __builtin_amdgcn_sched_barrier(0);
      }
    }
  }
  __device__ __forceinline__ void operator()(const f32x4 (&acc)[2][2][4][2], const Unit& u, int wr, int wc, int fr, int fq) const {
    const bool sunit = u.pm >= MP / 256;
    const int r00 = u.pm * 256 + wr * 64 + fr;
    const int p0 = sunit ? 2048 + fr : (r00 & 4095);
#pragma unroll
    for (int bj = 0; bj < 2; ++bj) {
      int grp, off;
      slot_info(u.pn * 8 + bj * 4 + wc, grp, off);
      if (grp == G_PAD) continue;
      const int c0 = off + 8 * fq;
      const bool dorope = (grp == G_Q || grp == G_K || grp == G_QI) && ((off & 63) == 0);
      const float scale = (grp == G_Q || grp == G_QI) ? 0.125f : 1.0f;
      bf16_t* bdst;
      int bstride;
      float* fdst = nullptr;
      switch (grp) {
        case G_Q: bdst = (bf16_t*)(ws + W_Q); bstride = 512; break;
        case G_QI: bdst = (bf16_t*)(ws + W_QI); bstride = 256; break;
        case G_K: bdst = (bf16_t*)(ws + (sunit ? W_KS : W_KP)); bstride = 128; fdst = out + (sunit ? O_SK : O_PK); break;
        case G_V: bdst = (bf16_t*)(ws + (sunit ? W_VS : W_VP)); bstride = 128; fdst = out + (sunit ? O_SV : O_PV); break;
        case G_U: bdst = (bf16_t*)(ws + W_U); bstride = 512; break;
        case G_VG: bdst = (bf16_t*)(ws + W_VG); bstride = 512; break;
        case G_GA: bdst = (bf16_t*)(ws + W_GA); bstride = 1024; break;
        case G_GB: bdst = (bf16_t*)(ws + W_GB); bstride = 1024; break;
        default: bdst = nullptr; bstride = 0; break;
      }
      if (dorope) slot<0>(acc, bj, r00, p0, sunit, fq, c0, bdst, bstride, fdst, scale);
      else if (grp == G_GA || grp == G_GB) slot<2>(acc, bj, r00, p0, sunit, fq, c0, bdst, bstride, fdst, scale);
      else if (grp == G_KI) slot<3>(acc, bj, r00, p0, sunit, fq, c0, bdst, bstride, fdst, scale);
      else if (grp == G_WI) slot<4>(acc, bj, r00, p0, sunit, fq, c0, bdst, bstride, fdst, scale);
      else slot<1>(acc, bj, r00, p0, sunit, fq, c0, bdst, bstride, fdst, scale);
    }
  }
};

struct EpiGate {
  static constexpr bool PERM = true;
  const unsigned char* ga;
  const unsigned char* gb;
  bf16_t* mrg;
  __device__ __forceinline__ void operator()(const f32x4 (&acc)[2][2][4][2], const Unit& u, int wr, int wc, int fr, int fq) const {
    const unsigned char* gate = u.which ? gb : ga;
#pragma unroll
    for (int ai = 0; ai < 2; ++ai) {
      u32x2 gw[4][2];
      u32x4 pw[4][2];
#pragma unroll
      for (int m = 0; m < 4; ++m)
#pragma unroll
        for (int bj = 0; bj < 2; ++bj) {
          const size_t o = (size_t)(u.pm * 256 + ai * 128 + wr * 64 + m * 16 + fr) * 1024 + u.pn * 256 + bj * 128 + wc * 32 + 8 * fq;
          gw[m][bj] = *(const u32x2*)(gate + o);
          pw[m][bj] = (u32x4){0u, 0u, 0u, 0u};
          if (u.which) pw[m][bj] = *(const u32x4*)(mrg + o);
        }
#pragma unroll
      for (int m = 0; m < 4; ++m)
#pragma unroll
        for (int bj = 0; bj < 2; ++bj) {
          const size_t o = (size_t)(u.pm * 256 + ai * 128 + wr * 64 + m * 16 + fr) * 1024 + u.pn * 256 + bj * 128 + wc * 32 + 8 * fq;
          float v[8];
#pragma unroll
          for (int e = 0; e < 8; ++e) v[e] = (float)((gw[m][bj][e >> 2] >> (8 * (e & 3))) & 0xffu) * (1.f / 255.f) * acc[ai][bj][m][e >> 2][e & 3];
#pragma unroll
          for (int e = 0; e < 4; ++e) { v[2 * e] += bflo(pw[m][bj][e]); v[2 * e + 1] += bfhi(pw[m][bj][e]); }
          u32x4 w;
#pragma unroll
          for (int e = 0; e < 4; ++e) w[e] = cvt_pk_bf16(v[2 * e], v[2 * e + 1]);
          *(u32x4*)(mrg + o) = w;
        }
    }
  }
};

struct EpiRes {
  static constexpr bool PERM = false;
  const float* xp;
  const bf16_t* xb;
  float* R;
  float* part;
  __device__ __forceinline__ void operator()(const f32x4 (&acc)[2][2][4][2], const Unit& u, int wr, int wc, int fr, int fq) const {
    if (u.split) {
      float* pbase = part + (size_t)(u.kt0 / u.nt) * MS * 1024;
#pragma unroll
      for (int ai = 0; ai < 2; ++ai)
#pragma unroll
        for (int m = 0; m < 4; ++m) {
          float* orow = pbase + (size_t)(u.pm * 256 + ai * 128 + wr * 64 + m * 16 + fr - MP) * 1024;
#pragma unroll
          for (int bj = 0; bj < 2; ++bj)
#pragma unroll
            for (int n = 0; n < 2; ++n) *(f32x4*)(orow + u.pn * 256 + bj * 128 + wc * 32 + 16 * n + 4 * fq) = acc[ai][bj][m][n];
        }
      return;
    }
    if (xp) {
#pragma unroll
      for (int ai = 0; ai < 2; ++ai)
#pragma unroll
        for (int mp = 0; mp < 2; ++mp) {
          f32x4 xr[2][2][2];
#pragma unroll
          for (int mm = 0; mm < 2; ++mm)
#pragma unroll
            for (int bj = 0; bj < 2; ++bj)
#pragma unroll
              for (int n = 0; n < 2; ++n)
                xr[mm][bj][n] = *(const f32x4*)(xp + (size_t)(u.pm * 256 + ai * 128 + wr * 64 + (mp * 2 + mm) * 16 + fr) * 1024 + u.pn * 256 + bj * 128 + wc * 32 + 16 * n + 4 * fq);
#pragma unroll
          for (int mm = 0; mm < 2; ++mm)
#pragma unroll
            for (int bj = 0; bj < 2; ++bj)
#pragma unroll
              for (int n = 0; n < 2; ++n) {
                const size_t o = (size_t)(u.pm * 256 + ai * 128 + wr * 64 + (mp * 2 + mm) * 16 + fr) * 1024 + u.pn * 256 + bj * 128 + wc * 32 + 16 * n + 4 * fq;
                *(f32x4*)(R + o) = xr[mm][bj][n] * ALPHA + acc[ai][bj][mp * 2 + mm][n];
              }
        }
    } else {
#pragma unroll
      for (int ai = 0; ai < 2; ++ai) {
        u32x2 xr[4][2][2];
#pragma unroll
        for (int m = 0; m < 4; ++m)
#pragma unroll
          for (int bj = 0; bj < 2; ++bj)
#pragma unroll
            for (int n = 0; n < 2; ++n)
              xr[m][bj][n] = *(const u32x2*)(xb + (size_t)(u.pm * 256 + ai * 128 + wr * 64 + m * 16 + fr) * 1024 + u.pn * 256 + bj * 128 + wc * 32 + 16 * n + 4 * fq);
#pragma unroll
        for (int m = 0; m < 4; ++m)
#pragma unroll
          for (int bj = 0; bj < 2; ++bj)
#pragma unroll
            for (int n = 0; n < 2; ++n) {
              const size_t o = (size_t)(u.pm * 256 + ai * 128 + wr * 64 + m * 16 + fr) * 1024 + u.pn * 256 + bj * 128 + wc * 32 + 16 * n + 4 * fq;
              const u32x2 xw = xr[m][bj][n];
              const f32x4 x = (f32x4){bflo(xw[0]), bfhi(xw[0]), bflo(xw[1]), bfhi(xw[1])};
              *(f32x4*)(R + o) = x * ALPHA + acc[ai][bj][m][n];
            }
      }
    }
  }
};

struct EpiFF1 {
  static constexpr bool PERM = true;
  bf16_t* H;
  __device__ __forceinline__ void operator()(const f32x4 (&acc)[2][2][4][2], const Unit& u, int wr, int wc, int fr, int fq) const {
#pragma unroll
    for (int ai = 0; ai < 2; ++ai)
#pragma unroll
      for (int m = 0; m < 4; ++m) {
        const int r = u.pm * 256 + ai * 128 + wr * 64 + m * 16 + fr;
#pragma unroll
        for (int bj = 0; bj < 2; ++bj) {
          float v[8];
#pragma unroll
          for (int e = 0; e < 4; ++e) {
            const float a = fmaxf(acc[ai][bj][m][0][e], 0.f), b = fmaxf(acc[ai][bj][m][1][e], 0.f);
            v[e] = a * a; v[4 + e] = b * b;
          }
          u32x4 w;
#pragma unroll
          for (int e = 0; e < 4; ++e) w[e] = cvt_pk_bf16(v[2 * e], v[2 * e + 1]);
          *(u32x4*)(H + (size_t)r * LDH + u.pn * 256 + bj * 128 + wc * 32 + 8 * fq) = w;
        }
      }
  }
};

__device__ __forceinline__ void cvt_rows(const float* __restrict__ src, bf16_t* __restrict__ dst, size_t n4, size_t gtid, size_t gn) {
  for (size_t i0 = gtid; i0 < n4; i0 += 4 * gn) {
    f32x4 v[4];
#pragma unroll
    for (int q = 0; q < 4; ++q) { const size_t i = i0 + q * gn; v[q] = i < n4 ? *(const f32x4*)(src + i * 4) : (f32x4){0.f, 0.f, 0.f, 0.f}; }
#pragma unroll
    for (int q = 0; q < 4; ++q) {
      const size_t i = i0 + q * gn;
      if (i < n4) { u32x2 w; w[0] = cvt_pk_bf16(v[q][0], v[q][1]); w[1] = cvt_pk_bf16(v[q][2], v[q][3]); *(u32x2*)(dst + i * 4) = w; }
    }
  }
}

struct TTile { const float* src; bf16_t* dst; int ldsrc, K, k0, n0; bool winmap; };
__device__ __forceinline__ TTile prep_tile(KP kp, unsigned char* ws, int j) {
  TTile t;
  t.winmap = false;
  int jj = j;
  if (jj < 2176) {
    const int l = jj / 1088, q = jj % 1088;
    t.src = kp->w_in + (size_t)l * 1024 * 4164; t.ldsrc = 4164; t.dst = (bf16_t*)(ws + W_WIN) + (size_t)l * 4352 * 1024; t.K = 1024; t.n0 = (q / 16) * 64; t.k0 = (q % 16) * 64; t.winmap = true;
    return t;
  }
  jj -= 2176;
  if (jj < 512) {
    const int which = jj / 256, t2 = jj % 256, l = t2 / 128, q = t2 % 128;
    t.src = (which ? kp->w_pb : kp->w_pa) + (size_t)l * 512 * 1024; t.ldsrc = 1024; t.dst = (bf16_t*)(ws + (which ? W_WPB : W_WPA)) + (size_t)l * 1024 * 512; t.K = 512; t.n0 = (q / 8) * 64; t.k0 = (q % 8) * 64;
    return t;
  }
  jj -= 512;
  if (jj < 512) {
    const int l = jj / 256, q = jj % 256;
    t.src = kp->w_out + (size_t)l * 1024 * 1024; t.ldsrc = 1024; t.dst = (bf16_t*)(ws + W_WOUT) + (size_t)l * 1024 * 1024; t.K = 1024; t.n0 = (q / 16) * 64; t.k0 = (q % 16) * 64;
    return t;
  }
  jj -= 512;
  if (jj < 2048) {
    const int l = jj / 1024, q = jj % 1024;
    t.src = kp->w_ff1 + (size_t)l * 1024 * 4096; t.ldsrc = 4096; t.dst = (bf16_t*)(ws + W_FF1) + (size_t)l * 4096 * 1024; t.K = 1024; t.n0 = (q / 16) * 64; t.k0 = (q % 16) * 64;
    return t;
  }
  jj -= 2048;
  {
    const int l = jj / 1024, q = jj % 1024;
    t.src = kp->w_ff2 + (size_t)l * 4096 * 1024; t.ldsrc = 1024; t.dst = (bf16_t*)(ws + W_FF2) + (size_t)l * 1024 * LDH; t.K = LDH; t.n0 = (q / 64) * 64; t.k0 = (q % 64) * 64;
  }
  return t;
}
__device__ __forceinline__ void phase_prep(KP kp, unsigned char* shm) {
  kp = launder(kp);
  float* tl = (float*)shm;
  const int bid = blockIdx.x, nb = gridDim.x, tid = otid();
  unsigned char* ws = kp->ws;
  for (int j0 = bid * 4; j0 < 7296; j0 += nb * 4) {
    f32x4 v[4][2];
#pragma unroll
    for (int q = 0; q < 4; ++q) {
      const TTile t = prep_tile(kp, ws, j0 + q);
#pragma unroll
      for (int e = 0; e < 2; ++e) {
        const int idx = tid + e * 512, r = idx >> 4, c = (idx & 15) * 4;
        const int oc = t.winmap ? win_orig_col(t.n0 + c) : (t.n0 + c);
        v[q][e] = oc >= 0 ? *(const f32x4*)(t.src + (size_t)(t.k0 + r) * t.ldsrc + oc) : (f32x4){0.f, 0.f, 0.f, 0.f};
      }
    }
#pragma unroll
    for (int q = 0; q < 4; ++q)
#pragma unroll
      for (int e = 0; e < 2; ++e) {
        const int idx = tid + e * 512, r = idx >> 4, c = (idx & 15) * 4;
#pragma unroll
        for (int j = 0; j < 4; ++j) tl[q * 4160 + (c + j) * 65 + r] = v[q][e][j];
      }
    __syncthreads();
#pragma unroll
    for (int q = 0; q < 4; ++q) {
      const TTile t = prep_tile(kp, ws, j0 + q);
#pragma unroll
      for (int e = 0; e < 4; ++e) {
        const int idx = tid + e * 512, n = idx >> 5, kk = (idx & 31) * 2;
        *(unsigned*)(t.dst + (size_t)(t.n0 + n) * t.K + t.k0 + kk) = cvt_pk_bf16(tl[q * 4160 + n * 65 + kk], tl[q * 4160 + n * 65 + kk + 1]);
      }
    }
    __syncthreads();
  }
  const size_t gtid = (size_t)bid * 512 + tid, gn = (size_t)nb * 512;
  cvt_rows(kp->x_prompt, (bf16_t*)(ws + W_XBF), (size_t)MP * 256, gtid, gn);
  cvt_rows(kp->x_sample, (bf16_t*)(ws + W_XBF) + (size_t)MP * 1024, (size_t)MS * 256, gtid, gn);
  for (size_t i = gtid; i < (size_t)MS * 256; i += gn)
    *(f32x4*)(kp->out + O_Y + (size_t)MP * 1024 + i * 4) = *(const f32x4*)(kp->x_sample + i * 4) * ALPHA;
  for (size_t i0 = gtid; i0 < 2ull * 16 * 2048 * 32; i0 += 4 * gn) {
    f32x4 a[4], b[4];
#pragma unroll
    for (int q = 0; q < 4; ++q) {
      const size_t i = i0 + q * gn;
      const bool ok = i < 2ull * 16 * 2048 * 32;
      a[q] = ok ? *(const f32x4*)(kp->cache_k + i * 4) : (f32x4){0.f, 0.f, 0.f, 0.f};
      b[q] = ok ? *(const f32x4*)(kp->cache_v + i * 4) : (f32x4){0.f, 0.f, 0.f, 0.f};
    }
#pragma unroll
    for (int q = 0; q < 4; ++q) {
      const size_t i = i0 + q * gn;
      if (i < 2ull * 16 * 2048 * 32) {
        const size_t row = i >> 5, c4 = i & 31, lsb = row >> 11, rr = row & 2047;
        const size_t d = (lsb * 2080 + rr) * 128 + c4 * 4;
        u32x2 w;
        w[0] = cvt_pk_bf16(a[q][0], a[q][1]); w[1] = cvt_pk_bf16(a[q][2], a[q][3]);
        *(u32x2*)((bf16_t*)(ws + W_KS) + d) = w;
        w[0] = cvt_pk_bf16(b[q][0], b[q][1]); w[1] = cvt_pk_bf16(b[q][2], b[q][3]);
        *(u32x2*)((bf16_t*)(ws + W_VS) + d) = w;
      }
    }
  }
  for (size_t i0 = gtid; i0 < 2ull * 16 * 2048 * 16; i0 += 4 * gn) {
    f32x4 a[4];
#pragma unroll
    for (int q = 0; q < 4; ++q) { const size_t i = i0 + q * gn; a[q] = i < 2ull * 16 * 2048 * 16 ? *(const f32x4*)(kp->cache_ik + i * 4) : (f32x4){0.f, 0.f, 0.f, 0.f}; }
#pragma unroll
    for (int q = 0; q < 4; ++q) {
      const size_t i = i0 + q * gn;
      if (i < 2ull * 16 * 2048 * 16) {
        const size_t row = i >> 4, c4 = i & 15, lsb = row >> 11, rr = row & 2047;
        u32x2 w;
        w[0] = cvt_pk_bf16(a[q][0], a[q][1]); w[1] = cvt_pk_bf16(a[q][2], a[q][3]);
        *(u32x2*)((bf16_t*)(ws + W_KIS) + lsb * 2080 * 64 + kif_off((int)rr, (int)c4)) = w;
      }
    }
  }
  for (size_t i = gtid; i < 4096 * 8; i += gn) {
    const int pos = (int)(i >> 3), fi = (int)(i & 7);
    const float fr[8] = {1.0f, 0.1939227432012558f, 0.03760603070259094f, 0.007292664609849453f, 0.0014142135623842478f, 0.00027424818836152554f,
                         5.3182957344688475e-05f, 1.0313385246263351e-05f};
    float f = fr[0];
#pragma unroll
    for (int q = 1; q < 8; ++q) f = (fi == q) ? fr[q] : f;
    const float ang = (float)pos * f;
    double rev = (double)ang * 0.15915494309189535;
    rev -= floor(rev);
    const float t = (float)rev;
    float* d = (float*)(ws + W_ROPE) + i * 2;
    d[0] = __builtin_amdgcn_cosf(t);
    d[1] = __builtin_amdgcn_sinf(t);
  }
  for (size_t i = gtid; i < 2ull * 4 * 128 * 128; i += gn) {
    const int s = (int)(i & 127), t = (int)((i >> 7) & 127);
    const float v = s <= t ? kp->w_s[i] : 0.f;
    ((bf16_t*)(ws + W_WSM))[i] = (bf16_t)(cvt_pk_bf16(v, 0.f) & 0xffffu);
  }
}

__device__ __forceinline__ void phase_fix(KP kp, int l, unsigned char* shm) {
  kp = launder(kp);
  const int tid = otid(), lane = tid & 63, w = tid >> 6, bid = blockIdx.x, nb = gridDim.x;
  unsigned char* ws = kp->ws;
  const float* rope = (const float*)(ws + W_ROPE);
  {
    const int li = tid & 15;
    const f32x4 gg = *(const f32x4*)(kp->idx_g + l * 64 + li * 4), bb = *(const f32x4*)(kp->idx_b + l * 64 + li * 4);
    for (int rb = bid * 32; rb < MT; rb += nb * 32) {
      const int r = rb + (tid >> 4);
      const bool samp = r >= MP;
      const int sr = r - MP;
      const int pos = samp ? 2048 + (sr & 31) : (r & 4095);
      const f32x4 x = *(const f32x4*)((const float*)(ws + W_KIRAW) + (size_t)r * 64 + li * 4);
      float s = x[0] + x[1] + x[2] + x[3];
      s += __shfl_xor(s, 1); s += __shfl_xor(s, 2); s += __shfl_xor(s, 4); s += __shfl_xor(s, 8);
      const float mean = s * (1.f / 64.f);
      const f32x4 d = x - mean;
      float ss = d[0] * d[0] + d[1] * d[1] + d[2] * d[2] + d[3] * d[3];
      ss += __shfl_xor(ss, 1); ss += __shfl_xor(ss, 2); ss += __shfl_xor(ss, 4); ss += __shfl_xor(ss, 8);
      const float rstd = rsqrtf(ss * (1.f / 64.f) + LN_EPS);
      f32x4 y = d * rstd * gg + bb;
      f32x4 pr;
#pragma unroll
      for (int e = 0; e < 4; ++e) pr[e] = __shfl_xor(y[e], 2);
      if (li < 4) {
        const int i0 = (li & 1) * 4;
        const f32x4 t0 = *(const f32x4*)(rope + (size_t)pos * 16 + i0 * 2), t1 = *(const f32x4*)(rope + (size_t)pos * 16 + i0 * 2 + 4);
        const float cc[4] = {t0[0], t0[2], t1[0], t1[2]}, sn[4] = {t0[1], t0[3], t1[1], t1[3]};
#pragma unroll
        for (int e = 0; e < 4; ++e) y[e] = (li < 2) ? (y[e] * cc[e] - pr[e] * sn[e]) : (pr[e] * sn[e] + y[e] * cc[e]);
      }
      u32x2 wv;
      wv[0] = cvt_pk_bf16(y[0], y[1]); wv[1] = cvt_pk_bf16(y[2], y[3]);
      if (!samp) {
        *(f32x4*)(kp->out + O_PIK + ((size_t)l * MP + r) * 64 + li * 4) = y;
        *(u32x2*)((bf16_t*)(ws + W_KIP) + (size_t)(r >> 12) * 4096 * 64 + kif_off(r & 4095, li)) = wv;
      } else {
        *(f32x4*)(kp->out + O_SIK + ((size_t)l * MS + sr) * 64 + li * 4) = y;
        *(u32x2*)((bf16_t*)(ws + W_KIS) + (size_t)(l * 16 + (sr >> 5)) * 2080 * 64 + kif_off(2048 + (sr & 31), li)) = wv;
      }
    }
  }
  bf16_t* vnT = (bf16_t*)shm;
  const bf16_t* VG = (const bf16_t*)(ws + W_VG);
  bf16_t* U = (bf16_t*)(ws + W_U);
  const bf16_t* WSM = (const bf16_t*)(ws + W_WSM) + (size_t)l * 4 * 128 * 128;
  for (int tile = bid; tile < 272; tile += nb) {
    const bool samp = tile >= 256;
    const int rbase = samp ? MP + (tile - 256) * 32 : tile * 128;
    const int nrows = samp ? 32 : 128;
    {
      const int row = tid >> 2, qtr = tid & 3;
      if (row < nrows) {
        const bf16_t* src = VG + (size_t)(rbase + row) * 512 + qtr * 128;
        float s = 0.f, ss = 0.f;
#pragma unroll 4
        for (int e = 0; e < 16; ++e) {
          const u32x4 rw = *(const u32x4*)(src + e * 8);
#pragma unroll
          for (int q = 0; q < 4; ++q) { const float a = bflo(rw[q]), b = bfhi(rw[q]); s += a + b; ss += a * a + b * b; }
        }
        s += __shfl_xor(s, 1); s += __shfl_xor(s, 2);
        ss += __shfl_xor(ss, 1); ss += __shfl_xor(ss, 2);
        const float mean = s * (1.f / 512.f);
        const float var = fmaxf(ss * (1.f / 512.f) - mean * mean, 0.f);
        const float rstd = rsqrtf(var + LN_EPS);
        const float* gp = kp->sgu_g + l * 512 + qtr * 128;
        const float* bp = kp->sgu_b + l * 512 + qtr * 128;
        float* so = kp->out + O_SSV + ((size_t)l * MS + (rbase - MP) + row) * 512 + qtr * 128;
#pragma unroll 2
        for (int e = 0; e < 16; ++e) {
          const u32x4 rw = *(const u32x4*)(src + e * 8);
          const f32x4 g0 = *(const f32x4*)(gp + e * 8), g1 = *(const f32x4*)(gp + e * 8 + 4);
          const f32x4 b0 = *(const f32x4*)(bp + e * 8), b1 = *(const f32x4*)(bp + e * 8 + 4);
          float y[8];
#pragma unroll
          for (int q = 0; q < 4; ++q) {
            const float a = bflo(rw[q]), b = bfhi(rw[q]);
            const float ga = q < 2 ? g0[2 * q] : g1[2 * q - 4], gb = q < 2 ? g0[2 * q + 1] : g1[2 * q - 3];
            const float ba = q < 2 ? b0[2 * q] : b1[2 * q - 4], bb2 = q < 2 ? b0[2 * q + 1] : b1[2 * q - 3];
            y[2 * q] = (a - mean) * rstd * ga + ba;
            y[2 * q + 1] = (b - mean) * rstd * gb + bb2;
          }
          if (samp) {
            *(f32x4*)(so + e * 8) = (f32x4){y[0], y[1], y[2], y[3]};
            *(f32x4*)(so + e * 8 + 4) = (f32x4){y[4], y[5], y[6], y[7]};
          }
#pragma unroll
          for (int q = 0; q < 4; ++q) {
            const unsigned pk = cvt_pk_bf16(y[2 * q], y[2 * q + 1]);
            const int d = qtr * 128 + e * 8 + 2 * q;
            vnT[(size_t)d * 136 + row] = (bf16_t)(pk & 0xffffu);
            vnT[(size_t)(d + 1) * 136 + row] = (bf16_t)(pk >> 16);
          }
        }
      }
    }
    __syncthreads();
    if (!samp || w < 2) {
      const int tl = lane & 15, kg = lane >> 4;
      const int t = 16 * w + tl;
      const int r = rbase + t;
      for (int g = 0; g < 4; ++g) {
        f32x4 acc[8];
#pragma unroll
        for (int db = 0; db < 8; ++db) acc[db] = (f32x4){0.f, 0.f, 0.f, 0.f};
#pragma unroll
        for (int ks = 0; ks < 4; ++ks) {
          if (ks * 32 <= 16 * w + 15) {
            const bf16x8 wf = *(const bf16x8*)(WSM + ((size_t)g * 128 + t) * 128 + ks * 32 + kg * 8);
#pragma unroll
            for (int db = 0; db < 8; ++db) {
              const bf16x8 vf = *(const bf16x8*)(vnT + (size_t)(g * 128 + db * 16 + tl) * 136 + ks * 32 + kg * 8);
              acc[db] = __builtin_amdgcn_mfma_f32_16x16x32_bf16(vf, wf, acc[db], 0, 0, 0);
            }
          }
        }
        const float bias = kp->b_s[(l * 4 + g) * 128 + t];
#pragma unroll
        for (int db = 0; db < 8; ++db) {
          bf16_t* up = U + (size_t)r * 512 + g * 128 + db * 16 + kg * 4;
          const u32x2 uw = *(const u32x2*)up;
          u32x2 ow;
          ow[0] = cvt_pk_bf16(bflo(uw[0]) * (acc[db][0] + bias), bfhi(uw[0]) * (acc[db][1] + bias));
          ow[1] = cvt_pk_bf16(bflo(uw[1]) * (acc[db][2] + bias), bfhi(uw[1]) * (acc[db][3] + bias));
          *(u32x2*)up = ow;
        }
      }
    }
    __syncthreads();
  }
}

__device__ __forceinline__ int mbcnt64(unsigned long long m) { return __builtin_amdgcn_mbcnt_hi((unsigned)(m >> 32), __builtin_amdgcn_mbcnt_lo((unsigned)m, 0u)); }

template <int NB>
__device__ __forceinline__ void bisect256(const unsigned (&x)[64], unsigned& tau_out, int& cge_out) {
  unsigned tau = 0u;
  int cge = 0;
  for (int bit = 31; bit >= 0; --bit) {
    const unsigned cand = tau | (1u << bit);
    unsigned cl = 0u;
#pragma unroll
    for (int blk = 0; blk < NB; ++blk) {
      unsigned long long m0, m1, m2, m3, m4, m5, m6, m7;
      asm volatile(
          "v_cmp_ge_u32_e64 %1, %9, %17\n\tv_cmp_ge_u32_e64 %2, %10, %17\n\tv_cmp_ge_u32_e64 %3, %11, %17\n\tv_cmp_ge_u32_e64 %4, %12, %17\n\t"
          "v_cmp_ge_u32_e64 %5, %13, %17\n\tv_cmp_ge_u32_e64 %6, %14, %17\n\tv_cmp_ge_u32_e64 %7, %15, %17\n\tv_cmp_ge_u32_e64 %8, %16, %17\n\t"
          "v_addc_co_u32_e64 %0, %1, 0, %0, %1\n\tv_addc_co_u32_e64 %0, %2, 0, %0, %2\n\tv_addc_co_u32_e64 %0, %3, 0, %0, %3\n\t"
          "v_addc_co_u32_e64 %0, %4, 0, %0, %4\n\tv_addc_co_u32_e64 %0, %5, 0, %0, %5\n\tv_addc_co_u32_e64 %0, %6, 0, %0, %6\n\t"
          "v_addc_co_u32_e64 %0, %7, 0, %0, %7\n\tv_addc_co_u32_e64 %0, %8, 0, %0, %8"
          : "+v"(cl), "=&s"(m0), "=&s"(m1), "=&s"(m2), "=&s"(m3), "=&s"(m4), "=&s"(m5), "=&s"(m6), "=&s"(m7)
          : "v"(x[blk * 8 + 0]), "v"(x[blk * 8 + 1]), "v"(x[blk * 8 + 2]), "v"(x[blk * 8 + 3]), "v"(x[blk * 8 + 4]), "v"(x[blk * 8 + 5]),
            "v"(x[blk * 8 + 6]), "v"(x[blk * 8 + 7]), "v"(cand));
    }
    cl += (unsigned)__builtin_amdgcn_update_dpp(0, (int)cl, 0x111, 0xf, 0xf, true);
    cl += (unsigned)__builtin_amdgcn_update_dpp(0, (int)cl, 0x112, 0xf, 0xf, true);
    cl += (unsigned)__builtin_amdgcn_update_dpp(0, (int)cl, 0x114, 0xf, 0xf, true);
    cl += (unsigned)__builtin_amdgcn_update_dpp(0, (int)cl, 0x118, 0xf, 0xf, true);
    const int cnt = __builtin_amdgcn_readlane((int)cl, 15) + __builtin_amdgcn_readlane((int)cl, 31) + __builtin_amdgcn_readlane((int)cl, 47) +
                    __builtin_amdgcn_readlane((int)cl, 63);
    if (cnt >= 256) { tau = cand; cge = cnt; }
    if (cnt == 256) break;
  }
  tau_out = tau;
  cge_out = cge;
}

struct SelPre { bf16x8 af[4]; f32x4 wv[4]; bf16x8 b0[4][4]; };
__device__ __forceinline__ void sel_prefetch(SelPre& p, unsigned char* ws, int r0, const bf16_t* __restrict__ kib, int n, int w, int lane) {
  if (n <= 256) return;
  const int i = lane & 31, kg = lane >> 5;
  const bf16_t* qrow = (const bf16_t*)(ws + W_QI) + (size_t)(r0 + (i >> 2)) * 256 + (i & 3) * 64 + kg * 8;
#pragma unroll
  for (int ks = 0; ks < 4; ++ks) p.af[ks] = *(const bf16x8*)(qrow + ks * 16);
#pragma unroll
  for (int jj = 0; jj < 4; ++jj) p.wv[jj] = *(const f32x4*)((const float*)(ws + W_WI) + (size_t)(r0 + 2 * jj + kg) * 4);
}
__device__ __forceinline__ void sel_prefetch_keys(SelPre& p, const bf16_t* __restrict__ kib, int n, int w, int lane) {
  if (n <= 256) return;
  const int nkb = n >> 5;
#pragma unroll
  for (int u = 0; u < 4; ++u) {
    const int kbu = w + 8 * u < nkb ? w + 8 * u : w;
    const bf16_t* krow = kib + (size_t)kbu * 2048 + lane * 8;
#pragma unroll
    for (int ks = 0; ks < 4; ++ks) p.b0[u][ks] = *(const bf16x8*)(krow + ks * 512);
  }
}
__device__ __forceinline__ void select_group(unsigned char* ws, int r0, const bf16_t* __restrict__ kib, int n, float* sc, SelPre& pre, int nr0, const bf16_t* __restrict__ nkib, int nn) {
  const int tid = otid(), lane = tid & 63, w = tid >> 6;
  unsigned short* SEL = (unsigned short*)(ws + W_SEL);
  if (n <= 256) {
    unsigned short* selrow = SEL + (size_t)(r0 + w) * 256;
    for (int i = lane; i < n; i += 64) selrow[i] = (unsigned short)i;
    if (nn > 0) { sel_prefetch(pre, ws, nr0, nkib, nn, w, lane); sel_prefetch_keys(pre, nkib, nn, w, lane); }
    return;
  }
  {
    const int i = lane & 31, kg = lane >> 5;
    bf16x8 af[4];
    f32x4 wv[4];
#pragma unroll
    for (int ks = 0; ks < 4; ++ks) af[ks] = pre.af[ks];
#pragma unroll
    for (int jj = 0; jj < 4; ++jj) wv[jj] = pre.wv[jj];
    const int nkb = n >> 5;
    for (int kb0 = w; kb0 < nkb; kb0 += 32) {
      bf16x8 bfr[4][4];
      if (kb0 == w) {
#pragma unroll
        for (int u = 0; u < 4; ++u)
#pragma unroll
          for (int ks = 0; ks < 4; ++ks) bfr[u][ks] = pre.b0[u][ks];
      } else {
#pragma unroll
        for (int u = 0; u < 4; ++u) {
          const int kbu = kb0 + 8 * u < nkb ? kb0 + 8 * u : kb0;
          const bf16_t* krow = kib + (size_t)kbu * 2048 + lane * 8;
#pragma unroll
          for (int ks = 0; ks < 4; ++ks) bfr[u][ks] = *(const bf16x8*)(krow + ks * 512);
        }
      }
#pragma unroll
      for (int u = 0; u < 4; ++u) {
        if (kb0 + 8 * u < nkb) {
          const int key = (kb0 + 8 * u) * 32 + i;
          f32x16 acc;
#pragma unroll
          for (int e = 0; e < 16; ++e) acc[e] = 0.f;
#pragma unroll
          for (int ks = 0; ks < 4; ++ks) acc = __builtin_amdgcn_mfma_f32_32x32x16_bf16(af[ks], bfr[u][ks], acc, 0, 0, 0);
#pragma unroll
          for (int jj = 0; jj < 4; ++jj) {
            float sco = wv[jj][0] * fmaxf(acc[4 * jj], 0.f) + wv[jj][1] * fmaxf(acc[4 * jj + 1], 0.f) + wv[jj][2] * fmaxf(acc[4 * jj + 2], 0.f) +
                        wv[jj][3] * fmaxf(acc[4 * jj + 3], 0.f);
            sco += 0.0f;
            sc[(2 * jj + kg) * 4096 + key] = sco;
          }
        }
      }
    }
  }
  __syncthreads();
  if (nn > 0) sel_prefetch(pre, ws, nr0, nkib, nn, w, lane);
  {
    const float* rowl = sc + w * 4096 + lane;
    const int nreg = (n + 63) >> 6;
    const int nl = n - lane;
    unsigned x[64];
#pragma unroll
    for (int i = 0; i < 64; ++i) {
      const unsigned ub = __float_as_uint(rowl[i * 64]);
      const unsigned o = ub ^ ((unsigned)((int)ub >> 31) | 0x80000000u);
      x[i] = (i * 64 < nl) ? o : 0u;
    }
    unsigned tau = 0u;
    int cge = 0;
    switch ((nreg + 7) >> 3) {
      case 1: bisect256<1>(x, tau, cge); break;
      case 2: bisect256<2>(x, tau, cge); break;
      case 3: bisect256<3>(x, tau, cge); break;
      case 4: bisect256<4>(x, tau, cge); break;
      case 5: bisect256<5>(x, tau, cge); break;
      case 6: bisect256<6>(x, tau, cge); break;
      case 7: bisect256<7>(x, tau, cge); break;
      default: bisect256<8>(x, tau, cge); break;
    }
    unsigned tau2 = (unsigned)__builtin_amdgcn_readfirstlane((int)tau);
    asm volatile("" : "+s"(tau2));
    unsigned short* selrow = SEL + (size_t)(r0 + w) * 256;
    if (__builtin_amdgcn_readfirstlane(cge) == 256) {
      int myc = 0;
#pragma unroll
      for (int i = 0; i < 64; ++i) myc += (x[i] >= tau2) ? 1 : 0;
      int incl = myc;
#pragma unroll
      for (int d = 1; d < 64; d <<= 1) {
        const int t = __shfl_up(incl, d);
        incl += (lane >= d) ? t : 0;
      }
      int pos = incl - myc;
#pragma unroll
      for (int blk = 0; blk < 8; ++blk) {
        if (blk * 8 < nreg) {
#pragma unroll
          for (int i = blk * 8; i < blk * 8 + 8; ++i) {
            if (x[i] >= tau2) { selrow[pos] = (unsigned short)(i * 64 + lane); ++pos; }
          }
        }
      }
    } else {
      int cgt = 0;
#pragma unroll
      for (int blk = 0; blk < 8; ++blk) {
#pragma unroll
        for (int i = blk * 8; i < blk * 8 + 8; ++i) cgt += __popcll(__ballot(x[i] > tau2));
        __builtin_amdgcn_sched_barrier(0);
      }
      const int rem = 256 - cgt;
      int base = 0, taken = 0;
      unsigned tau3 = tau2;
      asm volatile("" : "+s"(tau3));
#pragma unroll
      for (int blk = 0; blk < 8; ++blk) {
        if (blk * 8 < nreg) {
#pragma unroll
          for (int i = blk * 8; i < blk * 8 + 8; ++i) {
            const bool gt = x[i] > tau3, eq = x[i] == tau3;
            const unsigned long long meq = __ballot(eq);
            const bool take = gt || (eq && (taken + mbcnt64(meq) < rem));
            const unsigned long long msel = __ballot(take);
            const int ps = base + mbcnt64(msel);
            if (take && ps < 256) selrow[ps] = (unsigned short)(i * 64 + lane);
            base += __popcll(msel);
            taken += __popcll(meq);
            __builtin_amdgcn_sched_barrier(0);
          }
        }
      }
    }
  }
  if (nn > 0) sel_prefetch_keys(pre, nkib, nn, w, lane);
  __syncthreads();
}

__device__ __forceinline__ void sel_params(unsigned char* ws, int l, int tile, int it, int& r0, const bf16_t*& kib, int& n) {
  if (tile < 256) {
    const int b = tile >> 5, cp = tile & 31, c = (it & 8) ? 63 - cp : cp;
    kib = (const bf16_t*)(ws + W_KIP) + (size_t)b * 4096 * 64;
    r0 = b * 4096 + c * 64 + (it & 7) * 8;
    n = 64 * (c + 1);
  } else {
    const int sb = tile - 256;
    kib = (const bf16_t*)(ws + W_KIS) + (size_t)(l * 16 + sb) * 2080 * 64;
    r0 = MP + sb * 32 + it * 8;
    n = 2080;
  }
}
__device__ __forceinline__ void phase_select(KP kp, int l, unsigned char* shm) {
  kp = launder(kp);
  float* sc = (float*)shm;
  unsigned char* ws = kp->ws;
  const int tid = otid(), lane = tid & 63, w = tid >> 6;
  for (int tile0 = blockIdx.x; tile0 < 272; tile0 += gridDim.x) {
    const int tile = tile0 < 256 ? (tile0 & 7) * 32 + (tile0 >> 3) : tile0;
    const int ng = tile >= 256 ? 4 : 16;
    SelPre pre;
    {
      int r0, n; const bf16_t* kib;
      sel_params(ws, l, tile, 0, r0, kib, n);
      sel_prefetch(pre, ws, r0, kib, n, w, lane);
      sel_prefetch_keys(pre, kib, n, w, lane);
    }
    for (int it = 0; it < ng; ++it) {
      int r0, n, nr0 = 0, nn = 0;
      const bf16_t *kib, *nkib = nullptr;
      sel_params(ws, l, tile, it, r0, kib, n);
      if (it + 1 < ng) sel_params(ws, l, tile, it + 1, nr0, nkib, nn);
      select_group(ws, r0, kib, n, sc, pre, nr0, nkib, nn);
    }
  }
}

__device__ __forceinline__ void phase_attn(KP kp, int l, unsigned char* shm) {
  kp = launder(kp);
  const int tid = otid(), lane = tid & 63, w = __builtin_amdgcn_readfirstlane(tid >> 6);
  unsigned char* ws = kp->ws;
  unsigned char* tileb = shm + w * 5120;
  unsigned short* selw = (unsigned short*)(shm + w * 5120 + 4608);
  const unsigned tr_addr = (unsigned)(size_t)tileb + (unsigned)((4 * (lane >> 4) + ((lane & 15) >> 2)) * 144 + (lane & 3) * 8);
  bf16_t* Q = (bf16_t*)(ws + W_Q);
  const unsigned short* SEL = (const unsigned short*)(ws + W_SEL);
  const int nn = lane & 15, kg = lane >> 4;
  const int ks8 = lane >> 3, dc = lane & 7;
  for (int q = blockIdx.x * 8 + w; q < MT; q += gridDim.x * 8) {
    int r = q;
    if (gridDim.x == 256 && q < MP) r = ((q >> 3) & 7) * 4096 + (q >> 11) * 256 + ((q >> 6) & 31) * 8 + (q & 7);
    const bf16_t *kbase, *vbase;
    int n;
    if (r < MP) {
      const int b = r >> 12, t = r & 4095;
      kbase = (const bf16_t*)(ws + W_KP) + (size_t)b * 4096 * 128;
      vbase = (const bf16_t*)(ws + W_VP) + (size_t)b * 4096 * 128;
      n = ((t >> 6) + 1) * 64;
    } else {
      const int sb = (r - MP) >> 5;
      kbase = (const bf16_t*)(ws + W_KS) + (size_t)(l * 16 + sb) * 2080 * 128;
      vbase = (const bf16_t*)(ws + W_VS) + (size_t)(l * 16 + sb) * 2080 * 128;
      n = 2080;
    }
    const int cnt = n < 256 ? n : 256;
    {
      u32x2 sv = *(const u32x2*)(SEL + (size_t)r * 256 + lane * 4);
      const int k0 = lane * 4;
      unsigned a0 = sv[0] & 0xffffu, a1 = sv[0] >> 16, a2 = sv[1] & 0xffffu, a3 = sv[1] >> 16;
      a0 = (k0 < cnt) ? a0 : 0u; a1 = (k0 + 1 < cnt) ? a1 : 0u; a2 = (k0 + 2 < cnt) ? a2 : 0u; a3 = (k0 + 3 < cnt) ? a3 : 0u;
      u32x2 o;
      o[0] = a0 | (a1 << 16); o[1] = a2 | (a3 << 16);
      *(u32x2*)(selw + lane * 4) = o;
    }
    __builtin_amdgcn_wave_barrier();
    bf16x8 kpre[8][2];
#pragma unroll
    for (int kvh = 0; kvh < 2; ++kvh) {
      bf16x8 bq0, bq1;
#pragma unroll
      for (int e = 0; e < 8; ++e) { bq0[e] = 0; bq1[e] = 0; }
      if (nn < 4) {
        const bf16_t* qp = Q + (size_t)r * 512 + (kvh * 4 + nn) * 64 + kg * 8;
        bq0 = *(const bf16x8*)qp;
        bq1 = *(const bf16x8*)(qp + 32);
      }
      f32x4 lg[16];
      for (int repQ = 0; repQ < ((PROBE & 128) ? 2 : 1); ++repQ)
      {
#pragma unroll
        for (int hb = 0; hb < 2; ++hb) {
          bf16x8 ka[8][2];
          if (kvh == 1 && hb == 0) {
#pragma unroll
            for (int k8 = 0; k8 < 8; ++k8) { ka[k8][0] = kpre[k8][0]; ka[k8][1] = kpre[k8][1]; }
          } else {
#pragma unroll
            for (int k8 = 0; k8 < 8; ++k8) {
              const int idx = selw[(hb * 8 + k8) * 16 + nn];
              const bf16_t* kp = kbase + (size_t)idx * 128 + kvh * 64 + kg * 8;
              ka[k8][0] = *(const bf16x8*)kp;
              ka[k8][1] = *(const bf16x8*)(kp + 32);
            }
          }
          __builtin_amdgcn_sched_barrier(0);
#pragma unroll
          for (int k8 = 0; k8 < 8; ++k8) {
            f32x4 a = (f32x4){0.f, 0.f, 0.f, 0.f};
            a = __builtin_amdgcn_mfma_f32_16x16x32_bf16(ka[k8][0], bq0, a, 0, 0, 0);
            a = __builtin_amdgcn_mfma_f32_16x16x32_bf16(ka[k8][1], bq1, a, 0, 0, 0);
            lg[hb * 8 + k8] = a;
          }
          __builtin_amdgcn_sched_barrier(0);
        }
      }
      u32x4 vr[32];
#pragma unroll
      for (int i = 0; i < 16; ++i) {
        const int idx = selw[i * 8 + ks8];
        vr[i] = *(const u32x4*)(vbase + (size_t)idx * 128 + kvh * 64 + dc * 8);
      }
      float mx = -1e30f;
#pragma unroll
      for (int kb = 0; kb < 16; ++kb)
#pragma unroll
        for (int j = 0; j < 4; ++j) {
          const int key = kb * 16 + kg * 4 + j;
          lg[kb][j] = key < cnt ? lg[kb][j] : -1e30f;
          mx = fmaxf(mx, lg[kb][j]);
        }
      mx = fmaxf(mx, __shfl_xor(mx, 16));
      mx = fmaxf(mx, __shfl_xor(mx, 32));
      float sum = 0.f;
#pragma unroll
      for (int kb = 0; kb < 16; ++kb)
#pragma unroll
        for (int j = 0; j < 4; ++j) { lg[kb][j] = __expf(lg[kb][j] - mx); sum += lg[kb][j]; }
      sum += __shfl_xor(sum, 16);
      sum += __shfl_xor(sum, 32);
      const float inv = 1.f / sum;
      bf16x8 pf[8];
#pragma unroll
      for (int s8 = 0; s8 < 8; ++s8) {
        u32x4 pk;
        pk[0] = cvt_pk_bf16(lg[2 * s8][0], lg[2 * s8][1]);
        pk[1] = cvt_pk_bf16(lg[2 * s8][2], lg[2 * s8][3]);
        pk[2] = cvt_pk_bf16(lg[2 * s8 + 1][0], lg[2 * s8 + 1][1]);
        pk[3] = cvt_pk_bf16(lg[2 * s8 + 1][2], lg[2 * s8 + 1][3]);
        pf[s8] = __builtin_bit_cast(bf16x8, pk);
      }
      f32x4 oacc[4];
#pragma unroll
      for (int c = 0; c < 4; ++c) oacc[c] = (f32x4){0.f, 0.f, 0.f, 0.f};
      for (int repV = 0; repV < ((PROBE & 256) ? 2 : 1); ++repV)
      {
        if (repV) {
#pragma unroll
          for (int c = 0; c < 4; ++c) oacc[c] = (f32x4){0.f, 0.f, 0.f, 0.f};
        }
#pragma unroll
        for (int i = 16; i < 32; ++i) {
          const int idx = selw[i * 8 + ks8];
          vr[i] = *(const u32x4*)(vbase + (size_t)idx * 128 + kvh * 64 + dc * 8);
        }
#pragma unroll
        for (int s8 = 0; s8 < 8; ++s8) {
#pragma unroll
          for (int it = 0; it < 4; ++it) *(u32x4*)(tileb + (it * 8 + ks8) * 144 + dc * 16) = vr[s8 * 4 + it];
          u32x2 t0, t1, t2, t3, t4, t5, t6, t7;
          asm volatile(
              "ds_read_b64_tr_b16 %0, %8\n\tds_read_b64_tr_b16 %1, %8 offset:2304\n\t"
              "ds_read_b64_tr_b16 %2, %8 offset:32\n\tds_read_b64_tr_b16 %3, %8 offset:2336\n\t"
              "ds_read_b64_tr_b16 %4, %8 offset:64\n\tds_read_b64_tr_b16 %5, %8 offset:2368\n\t"
              "ds_read_b64_tr_b16 %6, %8 offset:96\n\tds_read_b64_tr_b16 %7, %8 offset:2400\n\t"
              "s_waitcnt lgkmcnt(0)"
              : "=&v"(t0), "=&v"(t1), "=&v"(t2), "=&v"(t3), "=&v"(t4), "=&v"(t5), "=&v"(t6), "=&v"(t7)
              : "v"(tr_addr)
              : "memory");
          const bf16x8 a0 = __builtin_bit_cast(bf16x8, (u32x4){t0[0], t0[1], t1[0], t1[1]});
          const bf16x8 a1 = __builtin_bit_cast(bf16x8, (u32x4){t2[0], t2[1], t3[0], t3[1]});
          const bf16x8 a2 = __builtin_bit_cast(bf16x8, (u32x4){t4[0], t4[1], t5[0], t5[1]});
          const bf16x8 a3 = __builtin_bit_cast(bf16x8, (u32x4){t6[0], t6[1], t7[0], t7[1]});
          oacc[0] = __builtin_amdgcn_mfma_f32_16x16x32_bf16(a0, pf[s8], oacc[0], 0, 0, 0);
          oacc[1] = __builtin_amdgcn_mfma_f32_16x16x32_bf16(a1, pf[s8], oacc[1], 0, 0, 0);
          oacc[2] = __builtin_amdgcn_mfma_f32_16x16x32_bf16(a2, pf[s8], oacc[2], 0, 0, 0);
          oacc[3] = __builtin_amdgcn_mfma_f32_16x16x32_bf16(a3, pf[s8], oacc[3], 0, 0, 0);
          if (kvh == 0 && s8 == 3) {
#pragma unroll
            for (int k8 = 0; k8 < 8; ++k8) {
              const int idx = selw[k8 * 16 + nn];
              const bf16_t* kp = kbase + (size_t)idx * 128 + 64 + kg * 8;
              kpre[k8][0] = *(const bf16x8*)kp;
              kpre[k8][1] = *(const bf16x8*)(kp + 32);
            }
          }
        }
        __builtin_amdgcn_sched_barrier(0);
      }
      if (nn < 4) {
#pragma unroll
        for (int c = 0; c < 4; ++c) {
          u32x2 ow;
          ow[0] = cvt_pk_bf16(oacc[c][0] * inv, oacc[c][1] * inv);
          ow[1] = cvt_pk_bf16(oacc[c][2] * inv, oacc[c][3] * inv);
          *(u32x2*)((bf16_t*)(ws + W_OA) + (size_t)r * 512 + (kvh * 4 + nn) * 64 + 16 * c + 4 * kg) = ow;
        }
      }
      __builtin_amdgcn_wave_barrier();
    }
  }
}

__device__ __forceinline__ void phase_ln(float* R, const float* __restrict__ g, const float* __restrict__ b, bf16_t* xbf, float samp_scale, const float* __restrict__ part, int nsplit, bool f32_all) {
  const int tid = otid(), lane = tid & 63, gw = blockIdx.x * 8 + (tid >> 6), nw = gridDim.x * 8;
  f32x4 gv[4], bv[4];
#pragma unroll
  for (int i = 0; i < 4; ++i) { gv[i] = *(const f32x4*)(g + i * 256 + lane * 4); bv[i] = *(const f32x4*)(b + i * 256 + lane * 4); }
  for (int r = gw; r < MT; r += nw) {
    float* row = R + (size_t)r * 1024;
    f32x4 v[4];
#pragma unroll
    for (int i = 0; i < 4; ++i) v[i] = *(const f32x4*)(row + i * 256 + lane * 4);
    if (r >= MP) {
      for (int sp = 0; sp < nsplit; ++sp) {
        const float* prow = part + ((size_t)sp * MS + (r - MP)) * 1024;
#pragma unroll
        for (int i = 0; i < 4; ++i) v[i] = v[i] + *(const f32x4*)(prow + i * 256 + lane * 4);
      }
    }
    float s = 0.f;
#pragma unroll
    for (int i = 0; i < 4; ++i) s += v[i][0] + v[i][1] + v[i][2] + v[i][3];
#pragma unroll
    for (int o = 32; o >= 1; o >>= 1) s += __shfl_xor(s, o);
    const float mean = s * (1.f / 1024.f);
    float ss = 0.f;
#pragma unroll
    for (int i = 0; i < 4; ++i) { v[i] = v[i] - mean; ss += v[i][0] * v[i][0] + v[i][1] * v[i][1] + v[i][2] * v[i][2] + v[i][3] * v[i][3]; }
#pragma unroll
    for (int o = 32; o >= 1; o >>= 1) ss += __shfl_xor(ss, o);
    const float rstd = rsqrtf(ss * (1.f / 1024.f) + LN_EPS);
#pragma unroll
    for (int i = 0; i < 4; ++i) {
      const f32x4 y = v[i] * rstd * gv[i] + bv[i];
      if (r >= MP) *(f32x4*)(row + i * 256 + lane * 4) = y * samp_scale;
      else if (f32_all) *(f32x4*)(row + i * 256 + lane * 4) = y;
      if (xbf) {
        u32x2 wv;
        wv[0] = cvt_pk_bf16(y[0], y[1]); wv[1] = cvt_pk_bf16(y[2], y[3]);
        *(u32x2*)(xbf + (size_t)r * 1024 + i * 256 + lane * 4) = wv;
      }
    }
  }
}

__device__ __forceinline__ void tile32(const bf16_t* __restrict__ A, int lda, const bf16_t* __restrict__ Bt, int ldb, int K, int row0, int col0, int lane, f32x4 (&c)[2][2]) {
  const int i = lane & 15, kg = lane >> 4;
  const bf16_t* a0 = A + (size_t)(row0 + i) * lda + kg * 8;
  const bf16_t* a1 = a0 + (size_t)16 * lda;
  const bf16_t* b0 = Bt + (size_t)(col0 + i) * ldb + kg * 8;
  const bf16_t* b1 = b0 + (size_t)16 * ldb;
#pragma unroll 4
  for (int k = 0; k < K; k += 32) {
    const bf16x8 af0 = *(const bf16x8*)(a0 + k), af1 = *(const bf16x8*)(a1 + k), bf0 = *(const bf16x8*)(b0 + k), bf1 = *(const bf16x8*)(b1 + k);
    c[0][0] = __builtin_amdgcn_mfma_f32_16x16x32_bf16(af0, bf0, c[0][0], 0, 0, 0);
    c[0][1] = __builtin_amdgcn_mfma_f32_16x16x32_bf16(af0, bf1, c[0][1], 0, 0, 0);
    c[1][0] = __builtin_amdgcn_mfma_f32_16x16x32_bf16(af1, bf0, c[1][0], 0, 0, 0);
    c[1][1] = __builtin_amdgcn_mfma_f32_16x16x32_bf16(af1, bf1, c[1][1], 0, 0, 0);
  }
}
__device__ __forceinline__ void sample_proj(unsigned char* ws, int l) {
  const int tid = otid(), lane = tid & 63, gw = blockIdx.x * 8 + (tid >> 6), nw = gridDim.x * 8;
  const bf16_t* GA = (const bf16_t*)(ws + W_GA);
  const bf16_t* GB = (const bf16_t*)(ws + W_GB);
  bf16_t* MRG = (bf16_t*)(ws + W_MRG);
  for (int t = gw; t < 16 * 32; t += nw) {
    const int row0 = MP + (t >> 5) * 32, col0 = (t & 31) * 32;
    f32x4 ca[2][2], cb[2][2];
#pragma unroll
    for (int x = 0; x < 2; ++x)
#pragma unroll
      for (int y = 0; y < 2; ++y) { ca[x][y] = (f32x4){0.f, 0.f, 0.f, 0.f}; cb[x][y] = (f32x4){0.f, 0.f, 0.f, 0.f}; }
    tile32((const bf16_t*)(ws + W_OA), 512, (const bf16_t*)(ws + W_WPA) + (size_t)l * 1024 * 512, 512, 512, row0, col0, lane, ca);
    tile32((const bf16_t*)(ws + W_U), 512, (const bf16_t*)(ws + W_WPB) + (size_t)l * 1024 * 512, 512, 512, row0, col0, lane, cb);
#pragma unroll
    for (int rb = 0; rb < 2; ++rb)
#pragma unroll
      for (int cc = 0; cc < 2; ++cc)
#pragma unroll
        for (int j = 0; j < 4; ++j) {
          const size_t o = (size_t)(row0 + 16 * rb + (lane >> 4) * 4 + j) * 1024 + col0 + 16 * cc + (lane & 15);
          const float m = ((float)((const unsigned char*)GA)[o] * ca[rb][cc][j] + (float)((const unsigned char*)GB)[o] * cb[rb][cc][j]) * (1.f / 255.f);
          MRG[o] = (bf16_t)(cvt_pk_bf16(m, 0.f) & 0xffffu);
        }
  }
}
__device__ __forceinline__ void sample_ff1(unsigned char* ws, int l) {
  const int tid = otid(), lane = tid & 63, gw = blockIdx.x * 8 + (tid >> 6), nw = gridDim.x * 8;
  bf16_t* H = (bf16_t*)(ws + W_H);
  for (int t = gw; t < 16 * 128; t += nw) {
    const int row0 = MP + (t >> 7) * 32, col0 = (t & 127) * 32;
    f32x4 c[2][2];
#pragma unroll
    for (int x = 0; x < 2; ++x)
#pragma unroll
      for (int y = 0; y < 2; ++y) c[x][y] = (f32x4){0.f, 0.f, 0.f, 0.f};
    tile32((const bf16_t*)(ws + W_XBF), 1024, (const bf16_t*)(ws + W_FF1) + (size_t)l * 4096 * 1024, 1024, 1024, row0, col0, lane, c);
#pragma unroll
    for (int rb = 0; rb < 2; ++rb)
#pragma unroll
      for (int cc = 0; cc < 2; ++cc)
#pragma unroll
        for (int j = 0; j < 4; ++j) {
          const float a = fmaxf(c[rb][cc][j], 0.f);
          H[(size_t)(row0 + 16 * rb + (lane >> 4) * 4 + j) * LDH + col0 + 16 * cc + (lane & 15)] = (bf16_t)(cvt_pk_bf16(a * a, 0.f) & 0xffffu);
        }
  }
}

#define XB_TMO      128
#define XB_XCNT(j)  (256  + 64 * (j))
#define XB_XSUB(j)  (1280 + 64 * (j))
#define XB_XGEN(j)  (2304 + 64 * (j))
#define XB_TOP      3328
#define XB_TOPGEN   3392
#define XCD_BAR_WORDS 3456
#define XB_SPIN_CAP (1u << 18)
__device__ __forceinline__ unsigned xb_ld(unsigned* p) { return __hip_atomic_load(p, __ATOMIC_RELAXED, __HIP_MEMORY_SCOPE_AGENT); }
__device__ __forceinline__ unsigned xb_add(unsigned* p, unsigned v) { return __hip_atomic_fetch_add(p, v, __ATOMIC_RELAXED, __HIP_MEMORY_SCOPE_AGENT); }
__device__ __forceinline__ unsigned xb_xcc_id() { return (unsigned)__builtin_amdgcn_s_getreg((3 << 11) | 20) & 0xFu; }
#define XB_SPIN(cond, bar) do { unsigned _sp = 0; while (cond) { __builtin_amdgcn_s_sleep(1); \
    if ((++_sp & 255u) == 0u) { if (xb_ld(&(bar)[XB_TMO])) break; if (_sp > XB_SPIN_CAP) { atomicAdd(&(bar)[XB_TMO], 1u); break; } } } } while (0)
__device__ __forceinline__ void xcd_barrier_complete(unsigned* bar, unsigned x, unsigned& nloc, unsigned& nx) {
  const unsigned G = gridDim.x * gridDim.y * gridDim.z;
  unsigned sum, cnt, mine, sp = 0u;
  for (;;) {
    sum = 0u; cnt = 0u; mine = 0u;
#pragma unroll
    for (unsigned j = 0; j < 16; ++j) { const unsigned c = xb_ld(&bar[XB_XCNT(j)]); sum += c; cnt += (c > 0u) ? 1u : 0u; mine = (j == x) ? c : mine; }
    if (sum == G) break;
    __builtin_amdgcn_s_sleep(1);
    if ((++sp & 255u) == 0u) { if (xb_ld(&bar[XB_TMO])) break; if (sp > XB_SPIN_CAP) { atomicAdd(&bar[XB_TMO], 1u); break; } }
  }
  nloc = mine > 0u ? mine : 1u; nx = cnt > 0u ? cnt : 1u;
}
__device__ __forceinline__ void xcd_barrier(KP kp, volatile LAS unsigned* st) {
  asm volatile("s_waitcnt vmcnt(0)" ::: "memory");
  __syncthreads();
  if (threadIdx.x == 0) {
    unsigned* bar = (unsigned*)(launder(kp)->ws + W_BAR);
    const unsigned x = xb_xcc_id();
    __builtin_amdgcn_s_waitcnt(0);
    unsigned nloc = st[0], nx = st[1];
    if (nloc == 0u) { xcd_barrier_complete(bar, x, nloc, nx); st[0] = nloc; st[1] = nx; }
    const unsigned old = xb_add(&bar[XB_XSUB(x)], 1u);
    const unsigned gen = old / nloc;
    if (old + 1u == (gen + 1u) * nloc) {
      __builtin_amdgcn_fence(__ATOMIC_RELEASE, "agent");
      asm volatile("s_waitcnt vmcnt(0)" ::: "memory");
      const unsigned og = xb_add(&bar[XB_TOP], 1u);
      const unsigned tg = og / nx;
      if (og + 1u == (tg + 1u) * nx) xb_add(&bar[XB_TOPGEN], 1u);
      else XB_SPIN(xb_ld(&bar[XB_TOPGEN]) == tg, bar);
      __builtin_amdgcn_fence(__ATOMIC_ACQUIRE, "agent");
      xb_add(&bar[XB_XGEN(x)], 1u);
      asm volatile("s_waitcnt vmcnt(0)" ::: "memory");
    } else {
      XB_SPIN(xb_ld(&bar[XB_XGEN(x)]) == gen, bar);
      __builtin_amdgcn_fence(__ATOMIC_ACQUIRE, "agent");
      asm volatile("s_waitcnt vmcnt(0)" ::: "memory");
    }
  }
  __syncthreads();
}

#ifndef PH_MASK
#define PH_MASK 0xFFFF
#endif
__global__ void __launch_bounds__(512, 2) mega(Params p_unused) {
  extern __shared__ __attribute__((aligned(16))) unsigned char shm[];
  cg::grid_group grid = cg::this_grid();
  LAS unsigned char* lds = (LAS unsigned char*)shm;
  const KP kp0 = (KP)__builtin_amdgcn_kernarg_segment_ptr();
  volatile LAS unsigned* st = (volatile LAS unsigned*)(lds + 139264);
  if (threadIdx.x < 2) st[threadIdx.x] = 0u;
  __syncthreads();
  if (threadIdx.x == 0) (void)xb_add(&((unsigned*)(kp0->ws + W_BAR))[XB_XCNT(xb_xcc_id())], 1u);

  for (int rep = 0; rep < ((PROBE & 4) ? 2 : 1); ++rep)
  if (PH_MASK & 1) phase_prep(kp0, shm);
  if (kp0->ws == nullptr) grid.sync();
  xcd_barrier(kp0, st);
#pragma unroll 1
  for (int l = 0; l < 2; ++l) {
    for (int rep = 0; rep < ((PROBE & 1) ? 2 : 1); ++rep)
    if (PH_MASK & 2) {
      const KP kp = launder(kp0);
      unsigned char* ws = kp->ws;
      pg8::Gemm g{(bf16_t*)(ws + W_XBF), (const bf16_t*)(ws + W_WIN) + (size_t)l * NPK * 1024, MT, NPK, 1024, 1024, 1024, nullptr, nullptr};
      pg8::StaticOrder S;
      S.init(g.N, g.K, 1, gridDim.x, blockIdx.x);
      EpiIn E{l, kp->out, ws};
      pg8::gemm_phase(lds, g, S, E);
    }
    xcd_barrier(kp0, st);
    if (PH_MASK & 4) phase_fix(kp0, l, shm);
    xcd_barrier(kp0, st);
    for (int rep = 0; rep < ((PROBE & 2) ? 2 : 1); ++rep)
    if (PH_MASK & 8) phase_select(kp0, l, shm);
    xcd_barrier(kp0, st);
    for (int rep = 0; rep < ((PROBE & 32) ? 2 : 1); ++rep)
    if (PH_MASK & 16) phase_attn(kp0, l, shm);
    xcd_barrier(kp0, st);
    for (int rep = 0; rep < ((PROBE & 1024) ? 2 : 1); ++rep)
    if (PH_MASK & 32) {
      const KP kp = launder(kp0);
      unsigned char* ws = kp->ws;
      sample_proj(ws, l);
      pg8::StaticOrder S;
      S.init(1024, 512, 0, gridDim.x, blockIdx.x);
      {
        pg8::Gemm g{(const bf16_t*)(ws + W_OA), (const bf16_t*)(ws + W_WPA) + (size_t)l * 1024 * 512, MT, 1024, 512, 512, 512,
                    (const bf16_t*)(ws + W_U), (const bf16_t*)(ws + W_WPB) + (size_t)l * 1024 * 512};
        S.dual = 1;
        EpiGate E{(const unsigned char*)(ws + W_GA), (const unsigned char*)(ws + W_GB), (bf16_t*)(ws + W_MRG)};
        pg8::gemm_phase(lds, g, S, E);
      }
    }
    xcd_barrier(kp0, st);
    for (int rep = 0; rep < ((PROBE & 2048) ? 2 : 1); ++rep)
    if (PH_MASK & 64) {
      const KP kp = launder(kp0);
      unsigned char* ws = kp->ws;
      float* R = kp->out + O_Y;
      pg8::Gemm g{(bf16_t*)(ws + W_MRG), (const bf16_t*)(ws + W_WOUT) + (size_t)l * 1024 * 1024, MT, 1024, 1024, 1024, 1024, nullptr, nullptr};
      pg8::StaticOrder S;
      S.init(g.N, g.K, 4, gridDim.x, blockIdx.x);
      EpiRes E{l == 0 ? kp->x_prompt : nullptr, (const bf16_t*)(ws + W_XBF), R, (float*)(ws + W_PART)};
      pg8::gemm_phase(lds, g, S, E);
    }
    xcd_barrier(kp0, st);
    if (PH_MASK & 128) {
      const KP kp = launder(kp0);
      phase_ln(kp->out + O_Y, kp->ln1_g + l * 1024, kp->ln1_b + l * 1024, (bf16_t*)(kp->ws + W_XBF), ALPHA, (const float*)(kp->ws + W_PART), 4, false);
    }
    xcd_barrier(kp0, st);
    for (int rep = 0; rep < ((PROBE & 512) ? 2 : 1); ++rep)
    if (PH_MASK & 256) {
      const KP kp = launder(kp0);
      unsigned char* ws = kp->ws;
      sample_ff1(ws, l);
      pg8::Gemm g{(bf16_t*)(ws + W_XBF), (const bf16_t*)(ws + W_FF1) + (size_t)l * 4096 * 1024, MT, DFF, 1024, 1024, 1024, nullptr, nullptr};
      pg8::StaticOrder S;
      S.init(g.N, g.K, 0, gridDim.x, blockIdx.x);
      EpiFF1 E{(bf16_t*)(ws + W_H)};
      pg8::gemm_phase(lds, g, S, E);
    }
    xcd_barrier(kp0, st);
    for (int rep = 0; rep < ((PROBE & 4096) ? 2 : 1); ++rep)
    if (PH_MASK & 512) {
      const KP kp = launder(kp0);
      unsigned char* ws = kp->ws;
      float* R = kp->out + O_Y;
      pg8::Gemm g{(const bf16_t*)(ws + W_H), (const bf16_t*)(ws + W_FF2) + (size_t)l * 1024 * LDH, MT, 1024, 4096, LDH, LDH, nullptr, nullptr};
      pg8::StaticOrder S;
      S.init(g.N, g.K, 8, gridDim.x, blockIdx.x);
      EpiRes E{nullptr, (const bf16_t*)(ws + W_XBF), R, (float*)(ws + W_PART)};
      pg8::gemm_phase(lds, g, S, E);
    }
    xcd_barrier(kp0, st);
    if (PH_MASK & 1024) {
      const KP kp = launder(kp0);
      phase_ln(kp->out + O_Y, kp->ln2_g + l * 1024, kp->ln2_b + l * 1024, l == 0 ? (bf16_t*)(kp->ws + W_XBF) : nullptr, l == 0 ? ALPHA : 1.0f, (const float*)(kp->ws + W_PART), 8, l == 1);
    }
    xcd_barrier(kp0, st);
  }
  if (PROBE & 64) { for (int q = 0; q < 40; ++q) xcd_barrier(kp0, st); }
}

extern "C" void kernel_launch(void* const* d_in, const int* in_sizes, int n_in, void* d_out, int out_size, void* d_ws, size_t ws_size,
                              hipStream_t stream) {
  static int grid_blocks = 0;
  if (!grid_blocks) {
    int dev = 0, cus = 0, per_cu = 0;
    if (n_in != 21 || (size_t)out_size != O_END || ws_size < W_END) {
      fprintf(stderr, "kernel_launch: unexpected sizes n_in %d out %d ws %zu (need %zu)\n", n_in, out_size, ws_size, (size_t)W_END);
      grid_blocks = -1;
      return;
    }
    if (hipGetDevice(&dev) != hipSuccess || hipDeviceGetAttribute(&cus, hipDeviceAttributeMultiprocessorCount, dev) != hipSuccess) { grid_blocks = -1; return; }
    if (hipFuncSetAttribute((const void*)mega, hipFuncAttributeMaxDynamicSharedMemorySize, LDS_BYTES) != hipSuccess) { grid_blocks = -1; return; }
    if (hipOccupancyMaxActiveBlocksPerMultiprocessor(&per_cu, (const void*)mega, 512, LDS_BYTES) != hipSuccess || per_cu < 1) {
      fprintf(stderr, "kernel_launch: occupancy query says %d blocks/CU\n", per_cu);
      grid_blocks = -1;
      return;
    }
    grid_blocks = cus;
  }
  if (grid_blocks < 0) return;
  Params p{};
  const float** pp = (const float**)&p;
  for (int i = 0; i < 21; ++i) pp[i] = (const float*)d_in[i];
  p.out = (float*)d_out;
  p.ws = (unsigned char*)d_ws;
  if (hipMemsetAsync((unsigned char*)d_ws + W_BAR, 0, 16384, stream) != hipSuccess) { fprintf(stderr, "kernel_launch: memset of barrier words failed\n"); return; }
  void* args[] = {&p};
  hipError_t e = hipLaunchCooperativeKernel((void*)mega, dim3(grid_blocks), dim3(512), args, LDS_BYTES, stream);
  if (e != hipSuccess) fprintf(stderr, "cooperative launch failed: %s (grid %d)\n", hipGetErrorString(e), grid_blocks);
}
```

```cpp
#include <hip/hip_runtime.h>
#include <hip/hip_cooperative_groups.h>
#include <cstdio>
namespace cg = cooperative_groups;

#ifndef PROBE
#define PROBE 0
#endif
#define LAS __attribute__((address_space(3)))
typedef unsigned short bf16_t;
typedef short bf16x8 __attribute__((ext_vector_type(8)));
typedef float f32x4 __attribute__((ext_vector_type(4)));
typedef float f32x16 __attribute__((ext_vector_type(16)));
typedef unsigned u32x4 __attribute__((ext_vector_type(4)));
typedef unsigned u32x2 __attribute__((ext_vector_type(2)));

constexpr int MP = 32768, MS = 512, MT = 33280, DM = 1024, NPK = 4352, DFF = 4096;
constexpr int LDH = 4096 + 64;
constexpr float ALPHA = 1.41421356237f, LN_EPS = 1e-5f;
constexpr size_t O_Y = 0, O_PK = 34078720, O_PV = 42467328, O_PIK = 50855936, O_SK = 55050240, O_SV = 55181312, O_SIK = 55312384,
                 O_SSV = 55377920, O_END = 55902208;
constexpr size_t W_WIN = 0;
constexpr size_t W_WPA = W_WIN + 2ull * 4352 * 1024 * 2;
constexpr size_t W_WPB = W_WPA + 2ull * 1024 * 512 * 2;
constexpr size_t W_WOUT = W_WPB + 2ull * 1024 * 512 * 2;
constexpr size_t W_FF1 = W_WOUT + 2ull * 1024 * 1024 * 2;
constexpr size_t W_FF2 = W_FF1 + 2ull * 4096 * 1024 * 2;
constexpr size_t W_WSM = W_FF2 + 2ull * LDH * 1024 * 2;
constexpr size_t W_ROPE = W_WSM + 2ull * 4 * 128 * 128 * 2;
constexpr size_t W_XBF = W_ROPE + 4096ull * 16 * 4;
constexpr size_t W_BIG = W_XBF + (size_t)MT * 1024 * 2;
constexpr size_t W_Q = W_BIG;
constexpr size_t W_KP = W_Q + (size_t)MT * 512 * 2;
constexpr size_t W_VP = W_KP + (size_t)MP * 128 * 2;
constexpr size_t W_QI = W_VP + (size_t)MP * 128 * 2;
constexpr size_t W_KIP = W_QI + (size_t)MT * 256 * 2;
constexpr size_t W_KIRAW = W_KIP + (size_t)MP * 64 * 2;
constexpr size_t W_WI = W_KIRAW + (size_t)MT * 64 * 4;
constexpr size_t W_U = W_WI + (size_t)MT * 4 * 4;
constexpr size_t W_VG = W_U + (size_t)MT * 512 * 2;
constexpr size_t W_GA = W_VG + (size_t)MT * 512 * 2;
constexpr size_t W_GB = W_GA + (size_t)MT * 1024 * 2;
constexpr size_t W_BIGEND = W_GB + (size_t)MT * 1024 * 2;
constexpr size_t W_MRG = W_Q;
static_assert((size_t)MT * 1024 * 2 <= W_KIRAW - W_Q, "merged overlay");
constexpr size_t W_H = W_BIG;
static_assert((size_t)MT * LDH * 2 <= W_BIGEND - W_BIG, "H overlay");
constexpr size_t W_KS = W_BIGEND;
constexpr size_t W_VS = W_KS + 2ull * 16 * 2080 * 128 * 2;
constexpr size_t W_KIS = W_VS + 2ull * 16 * 2080 * 128 * 2;
constexpr size_t W_SEL = W_KIS + 2ull * 16 * 2080 * 64 * 2;
constexpr size_t W_OA = W_SEL + (size_t)MT * 256 * 2;
constexpr size_t W_PART = W_OA + (size_t)MT * 512 * 2;
constexpr size_t W_BAR = W_PART + 8ull * MS * 1024 * 4;
constexpr size_t W_END = W_BAR + 16384;

constexpr int LDS_BYTES = 139264 + 16;

struct Params {
  const float *x_prompt, *x_sample, *cache_k, *cache_v, *cache_ik, *w_in, *idx_g, *idx_b, *sgu_g, *sgu_b, *w_s, *b_s, *w_pa, *w_pb, *w_out,
      *ln1_g, *ln1_b, *w_ff1, *w_ff2, *ln2_g, *ln2_b;
  float* out;
  unsigned char* ws;
};

__device__ __forceinline__ unsigned cvt_pk_bf16(float lo, float hi) {
  unsigned r;
  asm volatile("v_cvt_pk_bf16_f32 %0, %1, %2" : "=v"(r) : "v"(lo), "v"(hi));
  return r;
}
template <class T> __device__ __forceinline__ T launder(T p) { asm volatile("" : "+s"(p)); return p; }
typedef const __attribute__((address_space(4))) Params* KP;
__device__ __forceinline__ int otid() { int t = threadIdx.x; asm volatile("" : "+v"(t)); return t; }
__device__ __forceinline__ float bflo(unsigned w) { return __uint_as_float(w << 16); }
__device__ __forceinline__ float bfhi(unsigned w) { return __uint_as_float(w & 0xffff0000u); }
__device__ __forceinline__ float bf2f(bf16_t b) { return __uint_as_float(((unsigned)b) << 16); }

__device__ __forceinline__ size_t kif_off(int key, int li  ) { return ((size_t)(((key >> 5) * 4 + (li >> 2)) * 64 + ((li >> 1) & 1) * 32 + (key & 31))) * 8 + (li & 1) * 4; }
enum { G_Q = 0, G_K, G_V, G_QI, G_KI, G_WI, G_U, G_VG, G_GA, G_GB, G_PAD };
__host__ __device__ __forceinline__ void slot_info(int S, int& grp, int& off) {
  if (S < 16) { grp = G_Q; off = 32 * S; }
  else if (S < 20) { grp = G_K; off = 32 * (S - 16); }
  else if (S < 24) { grp = G_V; off = 32 * (S - 20); }
  else if (S < 32) { grp = G_QI; off = 32 * (S - 24); }
  else if (S < 40) {
    if (S == 32) { grp = G_KI; off = 0; }
    else if (S == 33) { grp = G_WI; off = 0; }
    else if (S == 34) { grp = G_U; off = 0; }
    else if (S == 35) { grp = G_U; off = 32; }
    else if (S == 36) { grp = G_KI; off = 32; }
    else { grp = G_U; off = 32 * (S - 35); }
  }
  else if (S < 51) { grp = G_U; off = 32 * (S - 35); }
  else if (S < 67) { grp = G_VG; off = 32 * (S - 51); }
  else if (S < 99) { grp = G_GA; off = 32 * (S - 67); }
  else if (S < 131) { grp = G_GB; off = 32 * (S - 99); }
  else { grp = G_PAD; off = 0; }
}
__device__ __forceinline__ int win_orig_col(int p) {
  int grp, off;
  slot_info(p >> 5, grp, off);
  const int c = p & 31;
  switch (grp) {
    case G_Q: return off + c;
    case G_K: return 512 + off + c;
    case G_V: return 640 + off + c;
    case G_QI: return 768 + off + c;
    case G_KI: return 1024 + off + c;
    case G_WI: return c < 4 ? 1088 + c : -1;
    case G_U: return 1092 + off + c;
    case G_VG: return 1604 + off + c;
    case G_GA: return 2116 + off + c;
    case G_GB: return 3140 + off + c;
    default: return -1;
  }
}

namespace pg8 {
constexpr int BM = 256, BK = 64, HALF = 128, HTB = HALF * BK * 2, STAGE_BYTES = 8 * HTB, NXCD = 8, WGM = 8;
__host__ __device__ __forceinline__ int lds_byte(int r, int c) {
  const int st = (r >> 4) * 2 + (c >> 5), rr = r & 15, cc = c & 31, ob = rr * 64 + cc * 2;
  return st * 1024 + (ob ^ (((ob >> 9) & 1) << 5));
}
__host__ __device__ __forceinline__ void stage_rc(int b, int& R, int& C) {
  const int st = b / 1024, sb = b % 1024, swz = sb ^ (((sb >> 9) & 1) << 5);
  R = (st >> 1) * 16 + swz / 64;
  C = (st & 1) * 32 + (swz % 64) / 2;
}
__host__ __device__ __forceinline__ int perm32(int rho) { const int n = rho >> 4, i = rho & 15; return 8 * (i >> 2) + 4 * n + (i & 3); }
struct Unit { int pm, pn, kt0, nt, split, which; };
struct Gemm { const bf16_t* A; const bf16_t* Bt; int M, N, K, lda, ldb; const bf16_t* A2; const bf16_t* Bt2; };
struct StaticOrder {
  int nM, nN, nwg, nextra, splits, ntfull, G, c, dual;
  __device__ void init(int N, int K, int splits_, int G_, int c_) {
    nM = MP / BM; nN = N / BM; nwg = nM * nN; splits = splits_ > 0 ? splits_ : 1; nextra = 2 * nN * splits_; ntfull = K / BK; G = G_; c = c_; dual = 0;
  }
  __device__ bool next(int i, Unit& u) const {
    const long L = (long)(i >> dual) * G + c;
    u.which = dual ? (i & 1) : 0;
    if (L < nwg) {
      int wgid = (int)L;
      { const int q = nwg / NXCD, r = nwg % NXCD, xcd = wgid % NXCD, off = wgid / NXCD; wgid = (xcd < r ? xcd * (q + 1) : r * (q + 1) + (xcd - r) * q) + off; }
      const int nig = WGM * nN, gid = wgid / nig, fm = gid * WGM, gsz = (nM - fm) < WGM ? (nM - fm) : WGM;
      u.pm = fm + ((wgid % nig) % gsz);
      u.pn = (wgid % nig) / gsz;
      u.kt0 = 0; u.nt = ntfull; u.split = 0;
      return true;
    }
    const int j = (int)(L - nwg);
    if (j >= nextra) return false;
    const int per_panel = nN * splits;
    u.pm = nM + j / per_panel;
    const int rem = j % per_panel;
    u.pn = rem / splits;
    u.nt = ntfull / splits;
    u.kt0 = (rem % splits) * u.nt;
    u.split = splits > 1 ? 1 : 0;
    return true;
  }
};

template <class Epi>
__device__ __forceinline__ void gemm_phase(LAS unsigned char* lds, const Gemm g, const StaticOrder& S, const Epi& E) {
  const int tid = otid(), wid = __builtin_amdgcn_readfirstlane(tid >> 6), lane = tid & 63, wr = wid >> 2, wc = wid & 3, fr = lane & 15, fq = lane >> 4;
  const int K = g.K;
  unsigned voffA[2], voffB[2];
#pragma unroll
  for (int i = 0; i < 2; ++i) {
    int R, C;
    stage_rc(tid * 16 + i * 8192, R, C);
    const int Rb = Epi::PERM ? ((R & ~31) + perm32(R & 31)) : R;
    voffA[i] = (unsigned)(R * g.lda + C) * 2u;
    voffB[i] = (unsigned)(Rb * g.ldb + C) * 2u;
  }
  const size_t kstep = (size_t)(BK * 2);
  const size_t hstepA = (size_t)HALF * g.lda * 2, hstepB = (size_t)HALF * g.ldb * 2;
  const size_t tstepA = 2 * hstepA, tstepB = 2 * hstepB;
  const unsigned ldsw = (unsigned)wid * 1024u;
  const int aoff = lds_byte(wr * 64 + fr, fq * 8), boff = lds_byte(wc * 32 + fr, fq * 8);
#define PG8_SA(b, h) (((b) * 2 + (h)) * HTB)
#define PG8_SB(b, h) ((4 + (b) * 2 + (h)) * HTB)
#define PG8_STAGE(bufoff, gbase, voff) do { _Pragma("unroll") for (int _i = 0; _i < 2; ++_i) \
    __builtin_amdgcn_global_load_lds((const unsigned*)((const char*)(gbase) + (voff)[_i]), (LAS unsigned*)(lds + (bufoff) + ldsw + _i * 8192), 16, 0, 0); } while (0)
#define PG8_LDA(dst, b, h) do { _Pragma("unroll") for (int m = 0; m < 4; ++m) _Pragma("unroll") for (int k = 0; k < 2; ++k) dst[m][k] = *(const LAS bf16x8*)(lds + PG8_SA(b, h) + aoff + m * 2048 + k * 1024); } while (0)
#define PG8_LDB(dst, b, h) do { _Pragma("unroll") for (int n = 0; n < 2; ++n) _Pragma("unroll") for (int k = 0; k < 2; ++k) dst[n][k] = *(const LAS bf16x8*)(lds + PG8_SB(b, h) + boff + n * 2048 + k * 1024); } while (0)
#define PG8_MMA(ai, bj, At, Bt) do { __builtin_amdgcn_s_setprio(1); _Pragma("unroll") for (int m = 0; m < 4; ++m) _Pragma("unroll") for (int n = 0; n < 2; ++n) _Pragma("unroll") for (int k = 0; k < 2; ++k) \
    acc[ai][bj][m][n] = __builtin_amdgcn_mfma_f32_16x16x32_bf16(Bt[n][k], At[m][k], acc[ai][bj][m][n], 0, 0, 0); __builtin_amdgcn_s_setprio(0); } while (0)
#define PG8_WAIT_V(n) asm volatile("s_waitcnt vmcnt(" #n ")" ::: "memory")
#define PG8_WAIT_L(n) asm volatile("s_waitcnt lgkmcnt(" #n ")" ::: "memory")
#define PG8_BAR __builtin_amdgcn_s_barrier()
#define PG8_SCHED __builtin_amdgcn_sched_barrier(0)
  Unit cur, nxt;
  int ui = 0;
  if (!S.next(0, cur)) return;
  f32x4 acc[2][2][4][2];
#pragma unroll
  for (int a = 0; a < 2; ++a)
#pragma unroll
    for (int b = 0; b < 2; ++b)
#pragma unroll
      for (int m = 0; m < 4; ++m)
#pragma unroll
        for (int n = 0; n < 2; ++n) acc[a][b][m][n] = (f32x4){0.f, 0.f, 0.f, 0.f};
  bf16x8 At[4][2], B0[2][2], B1[2][2];
  const char* cA = (const char*)(cur.which ? g.A2 : g.A) + (size_t)cur.pm * tstepA + (size_t)cur.kt0 * kstep;
  const char* cB = (const char*)(cur.which ? g.Bt2 : g.Bt) + (size_t)cur.pn * tstepB + (size_t)cur.kt0 * kstep;
  PG8_STAGE(PG8_SB(0, 0), cB, voffB); PG8_STAGE(PG8_SA(0, 0), cA, voffA); PG8_STAGE(PG8_SB(0, 1), cB + hstepB, voffB); PG8_STAGE(PG8_SA(0, 1), cA + hstepA, voffA);
  if (wr == 1) PG8_BAR;
  PG8_WAIT_V(4); PG8_BAR;
  PG8_STAGE(PG8_SB(1, 0), cB + kstep, voffB); PG8_STAGE(PG8_SA(1, 0), cA + kstep, voffA); PG8_STAGE(PG8_SB(1, 1), cB + hstepB + kstep, voffB);
  PG8_WAIT_V(6); PG8_BAR;
  for (;;) {
    const bool has_next = S.next(ui + 1, nxt);
    const char* nA = has_next ? (const char*)(nxt.which ? g.A2 : g.A) + (size_t)nxt.pm * tstepA + (size_t)nxt.kt0 * kstep : cA;
    const char* nB = has_next ? (const char*)(nxt.which ? g.Bt2 : g.Bt) + (size_t)nxt.pn * tstepB + (size_t)nxt.kt0 * kstep : cB;
    const int nt = cur.nt;
    for (int t = 0; t < nt; t += 2) {
      const bool last = (t == nt - 2);
      const char* a1 = cA + (size_t)(t + 1) * kstep;
      const char* a2 = last ? nA : cA + (size_t)(t + 2) * kstep;
      const char* b2 = last ? nB : cB + (size_t)(t + 2) * kstep;
      const char* a3 = a2 + kstep;
      const char* b3 = b2 + kstep;
      PG8_LDB(B0, 0, 0); PG8_SCHED; PG8_LDA(At, 0, 0); PG8_STAGE(PG8_SA(1, 1), a1 + hstepA, voffA);
      PG8_WAIT_L(8); PG8_BAR; PG8_WAIT_L(0); PG8_MMA(0, 0, At, B0); PG8_BAR; PG8_SCHED;
      PG8_LDB(B1, 0, 1); PG8_STAGE(PG8_SB(0, 0), b2, voffB);
      PG8_BAR; PG8_WAIT_L(0); PG8_MMA(0, 1, At, B1); PG8_BAR;
      PG8_LDA(At, 0, 1); PG8_STAGE(PG8_SA(0, 0), a2, voffA);
      PG8_BAR; PG8_WAIT_L(0); PG8_MMA(1, 0, At, B0); PG8_BAR; PG8_SCHED;
      PG8_STAGE(PG8_SB(0, 1), b2 + hstepB, voffB);
      PG8_WAIT_V(6); PG8_BAR; PG8_MMA(1, 1, At, B1); PG8_BAR;
      PG8_LDB(B0, 1, 0); PG8_SCHED; PG8_LDA(At, 1, 0); PG8_STAGE(PG8_SA(0, 1), a2 + hstepA, voffA);
      PG8_WAIT_L(8); PG8_BAR; PG8_WAIT_L(0); PG8_MMA(0, 0, At, B0); PG8_BAR; PG8_SCHED;
      PG8_LDB(B1, 1, 1); PG8_STAGE(PG8_SB(1, 0), b3, voffB);
      PG8_BAR; PG8_WAIT_L(0); PG8_MMA(0, 1, At, B1); PG8_BAR;
      PG8_LDA(At, 1, 1); PG8_STAGE(PG8_SA(1, 0), a3, voffA);
      PG8_BAR; PG8_WAIT_L(0); PG8_MMA(1, 0, At, B0); PG8_BAR; PG8_SCHED;
      PG8_STAGE(PG8_SB(1, 1), b3 + hstepB, voffB);
      PG8_WAIT_V(6); PG8_BAR; PG8_MMA(1, 1, At, B1); PG8_BAR;
    }
    E(acc, cur, wr, wc, fr, fq);
    if (!has_next) break;
#pragma unroll
    for (int a = 0; a < 2; ++a)
#pragma unroll
      for (int b = 0; b < 2; ++b)
#pragma unroll
        for (int m = 0; m < 4; ++m)
#pragma unroll
          for (int n = 0; n < 2; ++n) acc[a][b][m][n] = (f32x4){0.f, 0.f, 0.f, 0.f};
    cur = nxt; cA = nA; cB = nB; ++ui;
  }
  PG8_WAIT_V(0);
  if (wr == 0) PG8_BAR;
  PG8_BAR;
#undef PG8_SA
#undef PG8_SB
#undef PG8_STAGE
#undef PG8_LDA
#undef PG8_LDB
#undef PG8_MMA
#undef PG8_WAIT_V
#undef PG8_WAIT_L
#undef PG8_BAR
#undef PG8_SCHED
}
}
using pg8::Unit;

struct EpiIn {
  static constexpr bool PERM = true;
  int l;
  float* out;
  unsigned char* ws;
  static __device__ __forceinline__ void rot_mul(f32x4 (&a)[4], const f32x4 (&b)[4]) {
#pragma unroll
    for (int e = 0; e < 4; ++e) {
      const f32x4 x = a[e], y = b[e];
      a[e] = (f32x4){x[0] * y[0] - x[1] * y[1], x[1] * y[0] + x[0] * y[1], x[2] * y[2] - x[3] * y[3], x[3] * y[2] + x[2] * y[3]};
    }
  }
  template <int CAT>
  __device__ __forceinline__ void slot(const f32x4 (&acc)[2][2][4][2], int bj, int r00, int p0, bool sunit, int fq, int c0, bf16_t* bdst, int bstride, float* fdst,
                                       float scale) const {
    const float* rope = (const float*)(ws + W_ROPE);
    const f32x4 r16[4] = {{-9.576594803e-01f, -2.879033167e-01f, -9.992462583e-01f, 3.881900626e-02f}, {8.243765167e-01f, 5.660418348e-01f, 9.932003015e-01f, 1.164180448e-01f}, {9.997440109e-01f, 2.262548617e-02f, 9.999903729e-01f, 4.387956933e-03f}, {9.999996380e-01f, 8.509272148e-04f, 9.999999864e-01f, 1.650141632e-04f}};
#pragma unroll
    for (int ai = 0; ai < 2; ++ai) {
      f32x4 csa[4];
      if (CAT == 0) {
        const int pa = sunit ? p0 : p0 + 128 * ai;
#pragma unroll
        for (int e = 0; e < 4; ++e) csa[e] = *(const f32x4*)(rope + (size_t)pa * 16 + e * 4);
      }
#pragma unroll
      for (int m = 0; m < 4; ++m) {
        const int r = r00 + ai * 128 + m * 16;
        const int sr = r - MP;
        float v[8];
#pragma unroll
        for (int e = 0; e < 4; ++e) {
          v[e] = bj == 0 ? acc[ai][0][m][0][e] : acc[ai][1][m][0][e];
          v[4 + e] = bj == 0 ? acc[ai][0][m][1][e] : acc[ai][1][m][1][e];
        }
        if (CAT == 0) {
          if (m == 2 && sunit) {
#pragma unroll
            for (int e = 0; e < 4; ++e) csa[e] = *(const f32x4*)(rope + (size_t)p0 * 16 + e * 4);
          }
          float pr[8];
#pragma unroll
          for (int e = 0; e < 8; ++e) pr[e] = __shfl_xor(v[e], 16);
          if (fq < 2) {
#pragma unroll
            for (int e2 = 0; e2 < 4; ++e2) {
              const f32x4 t = csa[e2];
              if (fq == 0) {
                v[2 * e2] = v[2 * e2] * t[0] - pr[2 * e2] * t[1];
                v[2 * e2 + 1] = v[2 * e2 + 1] * t[2] - pr[2 * e2 + 1] * t[3];
              } else {
                v[2 * e2] = pr[2 * e2] * t[1] + v[2 * e2] * t[0];
                v[2 * e2 + 1] = pr[2 * e2 + 1] * t[3] + v[2 * e2 + 1] * t[2];
              }
            }
          }
          if (m < 3) rot_mul(csa, r16);
        }
        if (CAT == 2) {
          unsigned q[8];
#pragma unroll
          for (int e = 0; e < 8; ++e) q[e] = (unsigned)(__frcp_rn(1.f + __expf(-v[e])) * 255.f + 0.5f);
          u32x2 w8;
          w8[0] = q[0] | (q[1] << 8) | (q[2] << 16) | (q[3] << 24);
          w8[1] = q[4] | (q[5] << 8) | (q[6] << 16) | (q[7] << 24);
          *(u32x2*)((unsigned char*)bdst + (size_t)r * 1024 + c0) = w8;
          continue;
        }
        if (CAT == 3) {
          float* d = (float*)(ws + W_KIRAW) + (size_t)r * 64 + c0;
          *(f32x4*)d = (f32x4){v[0], v[1], v[2], v[3]};
          *(f32x4*)(d + 4) = (f32x4){v[4], v[5], v[6], v[7]};
        } else if (CAT == 4) {
          if (fq == 0) *(f32x4*)((float*)(ws + W_WI) + (size_t)r * 4) = (f32x4){v[0] * 0.5f, v[1] * 0.5f, v[2] * 0.5f, v[3] * 0.5f};
        } else {
          u32x4 w;
#pragma unroll
          for (int e = 0; e < 4; ++e) w[e] = cvt_pk_bf16(v[2 * e] * scale, v[2 * e + 1] * scale);
          size_t brow = (size_t)r;
          if (fdst && sunit) brow = (size_t)(l * 16 + (sr >> 5)) * 2080 + 2048 + (sr & 31);
          *(u32x4*)(bdst + brow * bstride + c0) = w;
          if (fdst) {
            float* fp = fdst + ((size_t)(sunit ? l * MS + sr : l * MP + r)) * 128 + c0;
            *(f32x4*)fp = (f32x4){v[0], v[1], v[2], v[3]};
            *(f32x4*)(fp + 4) = (f32x4){v[4], v[5], v[6], v[7]};
          }
        }
        if (CAT == 0) __builtin_amdgcn_sched_barrier(0);
      }
    }
  }
  __device__ __forceinline__ void operator()(const f32x4 (&acc)[2][2][4][2], const Unit& u, int wr, int wc, int fr, int fq) const {
    const bool sunit = u.pm >= MP / 256;
    const int r00 = u.pm * 256 + wr * 64 + fr;
    const int p0 = sunit ? 2048 + fr : (r00 & 4095);
#pragma unroll
    for (int bj = 0; bj < 2; ++bj) {
      int grp, off;
      slot_info(u.pn * 8 + bj * 4 + wc, grp, off);
      if (grp == G_PAD) continue;
      const int c0 = off + 8 * fq;
      const bool dorope = (grp == G_Q || grp == G_K || grp == G_QI) && ((off & 63) == 0);
      const float scale = (grp == G_Q || grp == G_QI) ? 0.125f : 1.0f;
      bf16_t* bdst;
      int bstride;
      float* fdst = nullptr;
      switch (grp) {
        case G_Q: bdst = (bf16_t*)(ws + W_Q); bstride = 512; break;
        case G_QI: bdst = (bf16_t*)(ws + W_QI); bstride = 256; break;
        case G_K: bdst = (bf16_t*)(ws + (sunit ? W_KS : W_KP)); bstride = 128; fdst = out + (sunit ? O_SK : O_PK); break;
        case G_V: bdst = (bf16_t*)(ws + (sunit ? W_VS : W_VP)); bstride = 128; fdst = out + (sunit ? O_SV : O_PV); break;
        case G_U: bdst = (bf16_t*)(ws + W_U); bstride = 512; break;
        case G_VG: bdst = (bf16_t*)(ws + W_VG); bstride = 512; break;
        case G_GA: bdst = (bf16_t*)(ws + W_GA); bstride = 1024; break;
        case G_GB: bdst = (bf16_t*)(ws + W_GB); bstride = 1024; break;
        default: bdst = nullptr; bstride = 0; break;
      }
      if (dorope) slot<0>(acc, bj, r00, p0, sunit, fq, c0, bdst, bstride, fdst, scale);
      else if (grp == G_GA || grp == G_GB) slot<2>(acc, bj, r00, p0, sunit, fq, c0, bdst, bstride, fdst, scale);
      else if (grp == G_KI) slot<3>(acc, bj, r00, p0, sunit, fq, c0, bdst, bstride, fdst, scale);
      else if (grp == G_WI) slot<4>(acc, bj, r00, p0, sunit, fq, c0, bdst, bstride, fdst, scale);
      else slot<1>(acc, bj, r00, p0, sunit, fq, c0, bdst, bstride, fdst, scale);
    }
  }
};

struct EpiGate {
  static constexpr bool PERM = true;
  const unsigned char* ga;
  const unsigned char* gb;
  bf16_t* mrg;
  __device__ __forceinline__ void operator()(const f32x4 (&acc)[2][2][4][2], const Unit& u, int wr, int wc, int fr, int fq) const {
    const unsigned char* gate = u.which ? gb : ga;
#pragma unroll
    for (int ai = 0; ai < 2; ++ai) {
      u32x2 gw[4][2];
      u32x4 pw[4][2];
#pragma unroll
      for (int m = 0; m < 4; ++m)
#pragma unroll
        for (int bj = 0; bj < 2; ++bj) {
          const size_t o = (size_t)(u.pm * 256 + ai * 128 + wr * 64 + m * 16 + fr) * 1024 + u.pn * 256 + bj * 128 + wc * 32 + 8 * fq;
          gw[m][bj] = *(const u32x2*)(gate + o);
          pw[m][bj] = (u32x4){0u, 0u, 0u, 0u};
          if (u.which) pw[m][bj] = *(const u32x4*)(mrg + o);
        }
#pragma unroll
      for (int m = 0; m < 4; ++m)
#pragma unroll
        for (int bj = 0; bj < 2; ++bj) {
          const size_t o = (size_t)(u.pm * 256 + ai * 128 + wr * 64 + m * 16 + fr) * 1024 + u.pn * 256 + bj * 128 + wc * 32 + 8 * fq;
          float v[8];
#pragma unroll
          for (int e = 0; e < 8; ++e) v[e] = (float)((gw[m][bj][e >> 2] >> (8 * (e & 3))) & 0xffu) * (1.f / 255.f) * acc[ai][bj][m][e >> 2][e & 3];
#pragma unroll
          for (int e = 0; e < 4; ++e) { v[2 * e] += bflo(pw[m][bj][e]); v[2 * e + 1] += bfhi(pw[m][bj][e]); }
          u32x4 w;
#pragma unroll
          for (int e = 0; e < 4; ++e) w[e] = cvt_pk_bf16(v[2 * e], v[2 * e + 1]);
          *(u32x4*)(mrg + o) = w;
        }
    }
  }
};

struct EpiRes {
  static constexpr bool PERM = false;
  const float* xp;
  const bf16_t* xb;
  float* R;
  float* part;
  __device__ __forceinline__ void operator()(const f32x4 (&acc)[2][2][4][2], const Unit& u, int wr, int wc, int fr, int fq) const {
    if (u.split) {
      float* pbase = part + (size_t)(u.kt0 / u.nt) * MS * 1024;
#pragma unroll
      for (int ai = 0; ai < 2; ++ai)
#pragma unroll
        for (int m = 0; m < 4; ++m) {
          float* orow = pbase + (size_t)(u.pm * 256 + ai * 128 + wr * 64 + m * 16 + fr - MP) * 1024;
#pragma unroll
          for (int bj = 0; bj < 2; ++bj)
#pragma unroll
            for (int n = 0; n < 2; ++n) *(f32x4*)(orow + u.pn * 256 + bj * 128 + wc * 32 + 16 * n + 4 * fq) = acc[ai][bj][m][n];
        }
      return;
    }
    if (xp) {
#pragma unroll
      for (int ai = 0; ai < 2; ++ai)
#pragma unroll
        for (int mp = 0; mp < 2; ++mp) {
          f32x4 xr[2][2][2];
#pragma unroll
          for (int mm = 0; mm < 2; ++mm)
#pragma unroll
            for (int bj = 0; bj < 2; ++bj)
#pragma unroll
              for (int n = 0; n < 2; ++n)
                xr[mm][bj][n] = *(const f32x4*)(xp + (size_t)(u.pm * 256 + ai * 128 + wr * 64 + (mp * 2 + mm) * 16 + fr) * 1024 + u.pn * 256 + bj * 128 + wc * 32 + 16 * n + 4 * fq);
#pragma unroll
          for (int mm = 0; mm < 2; ++mm)
#pragma unroll
            for (int bj = 0; bj < 2; ++bj)
#pragma unroll
              for (int n = 0; n < 2; ++n) {
                const size_t o = (size_t)(u.pm * 256 + ai * 128 + wr * 64 + (mp * 2 + mm) * 16 + fr) * 1024 + u.pn * 256 + bj * 128 + wc * 32 + 16 * n + 4 * fq;
                *(f32x4*)(R + o) = xr[mm][bj][n] * ALPHA + acc[ai][bj][mp * 2 + mm][n];
              }
        }
    } else {
      u32x2 xr[2][4][2][2];
#pragma unroll
      for (int ai = 0; ai < 2; ++ai)
#pragma unroll
        for (int m = 0; m < 4; ++m)
#pragma unroll
          for (int bj = 0; bj < 2; ++bj)
#pragma unroll
            for (int n = 0; n < 2; ++n)
              xr[ai][m][bj][n] = *(const u32x2*)(xb + (size_t)(u.pm * 256 + ai * 128 + wr * 64 + m * 16 + fr) * 1024 + u.pn * 256 + bj * 128 + wc * 32 + 16 * n + 4 * fq);
#pragma unroll
      for (int ai = 0; ai < 2; ++ai)
#pragma unroll
        for (int m = 0; m < 4; ++m)
#pragma unroll
          for (int bj = 0; bj < 2; ++bj)
#pragma unroll
            for (int n = 0; n < 2; ++n) {
              const size_t o = (size_t)(u.pm * 256 + ai * 128 + wr * 64 + m * 16 + fr) * 1024 + u.pn * 256 + bj * 128 + wc * 32 + 16 * n + 4 * fq;
              const u32x2 xw = xr[ai][m][bj][n];
              const f32x4 x = (f32x4){bflo(xw[0]), bfhi(xw[0]), bflo(xw[1]), bfhi(xw[1])};
              *(f32x4*)(R + o) = x * ALPHA + acc[ai][bj][m][n];
            }
    }
  }
};

struct EpiFF1 {
  static constexpr bool PERM = true;
  bf16_t* H;
  __device__ __forceinline__ void operator()(const f32x4 (&acc)[2][2][4][2], const Unit& u, int wr, int wc, int fr, int fq) const {
#pragma unroll
    for (int ai = 0; ai < 2; ++ai)
#pragma unroll
      for (int m = 0; m < 4; ++m) {
        const int r = u.pm * 256 + ai * 128 + wr * 64 + m * 16 + fr;
#pragma unroll
        for (int bj = 0; bj < 2; ++bj) {
          float v[8];
#pragma unroll
          for (int e = 0; e < 4; ++e) {
            const float a = fmaxf(acc[ai][bj][m][0][e], 0.f), b = fmaxf(acc[ai][bj][m][1][e], 0.f);
            v[e] = a * a; v[4 + e] = b * b;
          }
          u32x4 w;
#pragma unroll
          for (int e = 0; e < 4; ++e) w[e] = cvt_pk_bf16(v[2 * e], v[2 * e + 1]);
          *(u32x4*)(H + (size_t)r * LDH + u.pn * 256 + bj * 128 + wc * 32 + 8 * fq) = w;
        }
      }
  }
};

__device__ __forceinline__ void cvt_rows(const float* __restrict__ src, bf16_t* __restrict__ dst, size_t n4, size_t gtid, size_t gn) {
  for (size_t i0 = gtid; i0 < n4; i0 += 4 * gn) {
    f32x4 v[4];
#pragma unroll
    for (int q = 0; q < 4; ++q) { const size_t i = i0 + q * gn; v[q] = i < n4 ? *(const f32x4*)(src + i * 4) : (f32x4){0.f, 0.f, 0.f, 0.f}; }
#pragma unroll
    for (int q = 0; q < 4; ++q) {
      const size_t i = i0 + q * gn;
      if (i < n4) { u32x2 w; w[0] = cvt_pk_bf16(v[q][0], v[q][1]); w[1] = cvt_pk_bf16(v[q][2], v[q][3]); *(u32x2*)(dst + i * 4) = w; }
    }
  }
}

struct TTile { const float* src; bf16_t* dst; int ldsrc, K, k0, n0; bool winmap; };
__device__ __forceinline__ TTile prep_tile(KP kp, unsigned char* ws, int j) {
  TTile t;
  t.winmap = false;
  int jj = j;
  if (jj < 2176) {
    const int l = jj / 1088, q = jj % 1088;
    t.src = kp->w_in + (size_t)l * 1024 * 4164; t.ldsrc = 4164; t.dst = (bf16_t*)(ws + W_WIN) + (size_t)l * 4352 * 1024; t.K = 1024; t.n0 = (q / 16) * 64; t.k0 = (q % 16) * 64; t.winmap = true;
    return t;
  }
  jj -= 2176;
  if (jj < 512) {
    const int which = jj / 256, t2 = jj % 256, l = t2 / 128, q = t2 % 128;
    t.src = (which ? kp->w_pb : kp->w_pa) + (size_t)l * 512 * 1024; t.ldsrc = 1024; t.dst = (bf16_t*)(ws + (which ? W_WPB : W_WPA)) + (size_t)l * 1024 * 512; t.K = 512; t.n0 = (q / 8) * 64; t.k0 = (q % 8) * 64;
    return t;
  }
  jj -= 512;
  if (jj < 512) {
    const int l = jj / 256, q = jj % 256;
    t.src = kp->w_out + (size_t)l * 1024 * 1024; t.ldsrc = 1024; t.dst = (bf16_t*)(ws + W_WOUT) + (size_t)l * 1024 * 1024; t.K = 1024; t.n0 = (q / 16) * 64; t.k0 = (q % 16) * 64;
    return t;
  }
  jj -= 512;
  if (jj < 2048) {
    const int l = jj / 1024, q = jj % 1024;
    t.src = kp->w_ff1 + (size_t)l * 1024 * 4096; t.ldsrc = 4096; t.dst = (bf16_t*)(ws + W_FF1) + (size_t)l * 4096 * 1024; t.K = 1024; t.n0 = (q / 16) * 64; t.k0 = (q % 16) * 64;
    return t;
  }
  jj -= 2048;
  {
    const int l = jj / 1024, q = jj % 1024;
    t.src = kp->w_ff2 + (size_t)l * 4096 * 1024; t.ldsrc = 1024; t.dst = (bf16_t*)(ws + W_FF2) + (size_t)l * 1024 * LDH; t.K = LDH; t.n0 = (q / 64) * 64; t.k0 = (q % 64) * 64;
  }
  return t;
}
__device__ __forceinline__ void phase_prep(KP kp, unsigned char* shm) {
  kp = launder(kp);
  float* tl = (float*)shm;
  const int bid = blockIdx.x, nb = gridDim.x, tid = otid();
  unsigned char* ws = kp->ws;
  for (int j0 = bid * 4; j0 < 7296; j0 += nb * 4) {
    f32x4 v[4][2];
#pragma unroll
    for (int q = 0; q < 4; ++q) {
      const TTile t = prep_tile(kp, ws, j0 + q);
#pragma unroll
      for (int e = 0; e < 2; ++e) {
        const int idx = tid + e * 512, r = idx >> 4, c = (idx & 15) * 4;
        const int oc = t.winmap ? win_orig_col(t.n0 + c) : (t.n0 + c);
        v[q][e] = oc >= 0 ? *(const f32x4*)(t.src + (size_t)(t.k0 + r) * t.ldsrc + oc) : (f32x4){0.f, 0.f, 0.f, 0.f};
      }
    }
#pragma unroll
    for (int q = 0; q < 4; ++q)
#pragma unroll
      for (int e = 0; e < 2; ++e) {
        const int idx = tid + e * 512, r = idx >> 4, c = (idx & 15) * 4;
#pragma unroll
        for (int j = 0; j < 4; ++j) tl[q * 4160 + (c + j) * 65 + r] = v[q][e][j];
      }
    __syncthreads();
#pragma unroll
    for (int q = 0; q < 4; ++q) {
      const TTile t = prep_tile(kp, ws, j0 + q);
#pragma unroll
      for (int e = 0; e < 4; ++e) {
        const int idx = tid + e * 512, n = idx >> 5, kk = (idx & 31) * 2;
        *(unsigned*)(t.dst + (size_t)(t.n0 + n) * t.K + t.k0 + kk) = cvt_pk_bf16(tl[q * 4160 + n * 65 + kk], tl[q * 4160 + n * 65 + kk + 1]);
      }
    }
    __syncthreads();
  }
  const size_t gtid = (size_t)bid * 512 + tid, gn = (size_t)nb * 512;
  cvt_rows(kp->x_prompt, (bf16_t*)(ws + W_XBF), (size_t)MP * 256, gtid, gn);
  cvt_rows(kp->x_sample, (bf16_t*)(ws + W_XBF) + (size_t)MP * 1024, (size_t)MS * 256, gtid, gn);
  for (size_t i = gtid; i < (size_t)MS * 256; i += gn)
    *(f32x4*)(kp->out + O_Y + (size_t)MP * 1024 + i * 4) = *(const f32x4*)(kp->x_sample + i * 4) * ALPHA;
  for (size_t i0 = gtid; i0 < 2ull * 16 * 2048 * 32; i0 += 4 * gn) {
    f32x4 a[4], b[4];
#pragma unroll
    for (int q = 0; q < 4; ++q) {
      const size_t i = i0 + q * gn;
      const bool ok = i < 2ull * 16 * 2048 * 32;
      a[q] = ok ? *(const f32x4*)(kp->cache_k + i * 4) : (f32x4){0.f, 0.f, 0.f, 0.f};
      b[q] = ok ? *(const f32x4*)(kp->cache_v + i * 4) : (f32x4){0.f, 0.f, 0.f, 0.f};
    }
#pragma unroll
    for (int q = 0; q < 4; ++q) {
      const size_t i = i0 + q * gn;
      if (i < 2ull * 16 * 2048 * 32) {
        const size_t row = i >> 5, c4 = i & 31, lsb = row >> 11, rr = row & 2047;
        const size_t d = (lsb * 2080 + rr) * 128 + c4 * 4;
        u32x2 w;
        w[0] = cvt_pk_bf16(a[q][0], a[q][1]); w[1] = cvt_pk_bf16(a[q][2], a[q][3]);
        *(u32x2*)((bf16_t*)(ws + W_KS) + d) = w;
        w[0] = cvt_pk_bf16(b[q][0], b[q][1]); w[1] = cvt_pk_bf16(b[q][2], b[q][3]);
        *(u32x2*)((bf16_t*)(ws + W_VS) + d) = w;
      }
    }
  }
  for (size_t i0 = gtid; i0 < 2ull * 16 * 2048 * 16; i0 += 4 * gn) {
    f32x4 a[4];
#pragma unroll
    for (int q = 0; q < 4; ++q) { const size_t i = i0 + q * gn; a[q] = i < 2ull * 16 * 2048 * 16 ? *(const f32x4*)(kp->cache_ik + i * 4) : (f32x4){0.f, 0.f, 0.f, 0.f}; }
#pragma unroll
    for (int q = 0; q < 4; ++q) {
      const size_t i = i0 + q * gn;
      if (i < 2ull * 16 * 2048 * 16) {
        const size_t row = i >> 4, c4 = i & 15, lsb = row >> 11, rr = row & 2047;
        u32x2 w;
        w[0] = cvt_pk_bf16(a[q][0], a[q][1]); w[1] = cvt_pk_bf16(a[q][2], a[q][3]);
        *(u32x2*)((bf16_t*)(ws + W_KIS) + lsb * 2080 * 64 + kif_off((int)rr, (int)c4)) = w;
      }
    }
  }
  for (size_t i = gtid; i < 4096 * 8; i += gn) {
    const int pos = (int)(i >> 3), fi = (int)(i & 7);
    const float fr[8] = {1.0f, 0.1939227432012558f, 0.03760603070259094f, 0.007292664609849453f, 0.0014142135623842478f, 0.00027424818836152554f,
                         5.3182957344688475e-05f, 1.0313385246263351e-05f};
    float f = fr[0];
#pragma unroll
    for (int q = 1; q < 8; ++q) f = (fi == q) ? fr[q] : f;
    const float ang = (float)pos * f;
    double rev = (double)ang * 0.15915494309189535;
    rev -= floor(rev);
    const float t = (float)rev;
    float* d = (float*)(ws + W_ROPE) + i * 2;
    d[0] = __builtin_amdgcn_cosf(t);
    d[1] = __builtin_amdgcn_sinf(t);
  }
  for (size_t i = gtid; i < 2ull * 4 * 128 * 128; i += gn) {
    const int s = (int)(i & 127), t = (int)((i >> 7) & 127);
    const float v = s <= t ? kp->w_s[i] : 0.f;
    ((bf16_t*)(ws + W_WSM))[i] = (bf16_t)(cvt_pk_bf16(v, 0.f) & 0xffffu);
  }
}

__device__ __forceinline__ void phase_fix(KP kp, int l, unsigned char* shm) {
  kp = launder(kp);
  const int tid = otid(), lane = tid & 63, w = tid >> 6, bid = blockIdx.x, nb = gridDim.x;
  unsigned char* ws = kp->ws;
  const float* rope = (const float*)(ws + W_ROPE);
  {
    const int li = tid & 15;
    const f32x4 gg = *(const f32x4*)(kp->idx_g + l * 64 + li * 4), bb = *(const f32x4*)(kp->idx_b + l * 64 + li * 4);
    for (int rb = bid * 32; rb < MT; rb += nb * 32) {
      const int r = rb + (tid >> 4);
      const bool samp = r >= MP;
      const int sr = r - MP;
      const int pos = samp ? 2048 + (sr & 31) : (r & 4095);
      const f32x4 x = *(const f32x4*)((const float*)(ws + W_KIRAW) + (size_t)r * 64 + li * 4);
      float s = x[0] + x[1] + x[2] + x[3];
      s += __shfl_xor(s, 1); s += __shfl_xor(s, 2); s += __shfl_xor(s, 4); s += __shfl_xor(s, 8);
      const float mean = s * (1.f / 64.f);
      const f32x4 d = x - mean;
      float ss = d[0] * d[0] + d[1] * d[1] + d[2] * d[2] + d[3] * d[3];
      ss += __shfl_xor(ss, 1); ss += __shfl_xor(ss, 2); ss += __shfl_xor(ss, 4); ss += __shfl_xor(ss, 8);
      const float rstd = rsqrtf(ss * (1.f / 64.f) + LN_EPS);
      f32x4 y = d * rstd * gg + bb;
      f32x4 pr;
#pragma unroll
      for (int e = 0; e < 4; ++e) pr[e] = __shfl_xor(y[e], 2);
      if (li < 4) {
        const int i0 = (li & 1) * 4;
        const f32x4 t0 = *(const f32x4*)(rope + (size_t)pos * 16 + i0 * 2), t1 = *(const f32x4*)(rope + (size_t)pos * 16 + i0 * 2 + 4);
        const float cc[4] = {t0[0], t0[2], t1[0], t1[2]}, sn[4] = {t0[1], t0[3], t1[1], t1[3]};
#pragma unroll
        for (int e = 0; e < 4; ++e) y[e] = (li < 2) ? (y[e] * cc[e] - pr[e] * sn[e]) : (pr[e] * sn[e] + y[e] * cc[e]);
      }
      u32x2 wv;
      wv[0] = cvt_pk_bf16(y[0], y[1]); wv[1] = cvt_pk_bf16(y[2], y[3]);
      if (!samp) {
        *(f32x4*)(kp->out + O_PIK + ((size_t)l * MP + r) * 64 + li * 4) = y;
        *(u32x2*)((bf16_t*)(ws + W_KIP) + (size_t)(r >> 12) * 4096 * 64 + kif_off(r & 4095, li)) = wv;
      } else {
        *(f32x4*)(kp->out + O_SIK + ((size_t)l * MS + sr) * 64 + li * 4) = y;
        *(u32x2*)((bf16_t*)(ws + W_KIS) + (size_t)(l * 16 + (sr >> 5)) * 2080 * 64 + kif_off(2048 + (sr & 31), li)) = wv;
      }
    }
  }
  bf16_t* vnT = (bf16_t*)shm;
  const bf16_t* VG = (const bf16_t*)(ws + W_VG);
  bf16_t* U = (bf16_t*)(ws + W_U);
  const bf16_t* WSM = (const bf16_t*)(ws + W_WSM) + (size_t)l * 4 * 128 * 128;
  for (int tile = bid; tile < 272; tile += nb) {
    const bool samp = tile >= 256;
    const int rbase = samp ? MP + (tile - 256) * 32 : tile * 128;
    const int nrows = samp ? 32 : 128;
    {
      const int row = tid >> 2, qtr = tid & 3;
      if (row < nrows) {
        const bf16_t* src = VG + (size_t)(rbase + row) * 512 + qtr * 128;
        float s = 0.f, ss = 0.f;
#pragma unroll 4
        for (int e = 0; e < 16; ++e) {
          const u32x4 rw = *(const u32x4*)(src + e * 8);
#pragma unroll
          for (int q = 0; q < 4; ++q) { const float a = bflo(rw[q]), b = bfhi(rw[q]); s += a + b; ss += a * a + b * b; }
        }
        s += __shfl_xor(s, 1); s += __shfl_xor(s, 2);
        ss += __shfl_xor(ss, 1); ss += __shfl_xor(ss, 2);
        const float mean = s * (1.f / 512.f);
        const float var = fmaxf(ss * (1.f / 512.f) - mean * mean, 0.f);
        const float rstd = rsqrtf(var + LN_EPS);
        const float* gp = kp->sgu_g + l * 512 + qtr * 128;
        const float* bp = kp->sgu_b + l * 512 + qtr * 128;
        float* so = kp->out + O_SSV + ((size_t)l * MS + (rbase - MP) + row) * 512 + qtr * 128;
#pragma unroll 2
        for (int e = 0; e < 16; ++e) {
          const u32x4 rw = *(const u32x4*)(src + e * 8);
          const f32x4 g0 = *(const f32x4*)(gp + e * 8), g1 = *(const f32x4*)(gp + e * 8 + 4);
          const f32x4 b0 = *(const f32x4*)(bp + e * 8), b1 = *(const f32x4*)(bp + e * 8 + 4);
          float y[8];
#pragma unroll
          for (int q = 0; q < 4; ++q) {
            const float a = bflo(rw[q]), b = bfhi(rw[q]);
            const float ga = q < 2 ? g0[2 * q] : g1[2 * q - 4], gb = q < 2 ? g0[2 * q + 1] : g1[2 * q - 3];
            const float ba = q < 2 ? b0[2 * q] : b1[2 * q - 4], bb2 = q < 2 ? b0[2 * q + 1] : b1[2 * q - 3];
            y[2 * q] = (a - mean) * rstd * ga + ba;
            y[2 * q + 1] = (b - mean) * rstd * gb + bb2;
          }
          if (samp) {
            *(f32x4*)(so + e * 8) = (f32x4){y[0], y[1], y[2], y[3]};
            *(f32x4*)(so + e * 8 + 4) = (f32x4){y[4], y[5], y[6], y[7]};
          }
#pragma unroll
          for (int q = 0; q < 4; ++q) {
            const unsigned pk = cvt_pk_bf16(y[2 * q], y[2 * q + 1]);
            const int d = qtr * 128 + e * 8 + 2 * q;
            vnT[(size_t)d * 136 + row] = (bf16_t)(pk & 0xffffu);
            vnT[(size_t)(d + 1) * 136 + row] = (bf16_t)(pk >> 16);
          }
        }
      }
    }
    __syncthreads();
    if (!samp || w < 2) {
      const int tl = lane & 15, kg = lane >> 4;
      const int t = 16 * w + tl;
      const int r = rbase + t;
      for (int g = 0; g < 4; ++g) {
        f32x4 acc[8];
#pragma unroll
        for (int db = 0; db < 8; ++db) acc[db] = (f32x4){0.f, 0.f, 0.f, 0.f};
#pragma unroll
        for (int ks = 0; ks < 4; ++ks) {
          if (ks * 32 <= 16 * w + 15) {
            const bf16x8 wf = *(const bf16x8*)(WSM + ((size_t)g * 128 + t) * 128 + ks * 32 + kg * 8);
#pragma unroll
            for (int db = 0; db < 8; ++db) {
              const bf16x8 vf = *(const bf16x8*)(vnT + (size_t)(g * 128 + db * 16 + tl) * 136 + ks * 32 + kg * 8);
              acc[db] = __builtin_amdgcn_mfma_f32_16x16x32_bf16(vf, wf, acc[db], 0, 0, 0);
            }
          }
        }
        const float bias = kp->b_s[(l * 4 + g) * 128 + t];
#pragma unroll
        for (int db = 0; db < 8; ++db) {
          bf16_t* up = U + (size_t)r * 512 + g * 128 + db * 16 + kg * 4;
          const u32x2 uw = *(const u32x2*)up;
          u32x2 ow;
          ow[0] = cvt_pk_bf16(bflo(uw[0]) * (acc[db][0] + bias), bfhi(uw[0]) * (acc[db][1] + bias));
          ow[1] = cvt_pk_bf16(bflo(uw[1]) * (acc[db][2] + bias), bfhi(uw[1]) * (acc[db][3] + bias));
          *(u32x2*)up = ow;
        }
      }
    }
    __syncthreads();
  }
}

__device__ __forceinline__ int mbcnt64(unsigned long long m) { return __builtin_amdgcn_mbcnt_hi((unsigned)(m >> 32), __builtin_amdgcn_mbcnt_lo((unsigned)m, 0u)); }

template <int NB>
__device__ __forceinline__ void bisect256(const unsigned (&x)[64], unsigned& tau_out, int& cge_out) {
  unsigned tau = 0u;
  int cge = 0;
  for (int bit = 31; bit >= 0; --bit) {
    const unsigned cand = tau | (1u << bit);
    unsigned cl = 0u;
#pragma unroll
    for (int blk = 0; blk < NB; ++blk) {
      unsigned long long m0, m1, m2, m3, m4, m5, m6, m7;
      asm volatile(
          "v_cmp_ge_u32_e64 %1, %9, %17\n\tv_cmp_ge_u32_e64 %2, %10, %17\n\tv_cmp_ge_u32_e64 %3, %11, %17\n\tv_cmp_ge_u32_e64 %4, %12, %17\n\t"
          "v_cmp_ge_u32_e64 %5, %13, %17\n\tv_cmp_ge_u32_e64 %6, %14, %17\n\tv_cmp_ge_u32_e64 %7, %15, %17\n\tv_cmp_ge_u32_e64 %8, %16, %17\n\t"
          "v_addc_co_u32_e64 %0, %1, 0, %0, %1\n\tv_addc_co_u32_e64 %0, %2, 0, %0, %2\n\tv_addc_co_u32_e64 %0, %3, 0, %0, %3\n\t"
          "v_addc_co_u32_e64 %0, %4, 0, %0, %4\n\tv_addc_co_u32_e64 %0, %5, 0, %0, %5\n\tv_addc_co_u32_e64 %0, %6, 0, %0, %6\n\t"
          "v_addc_co_u32_e64 %0, %7, 0, %0, %7\n\tv_addc_co_u32_e64 %0, %8, 0, %0, %8"
          : "+v"(cl), "=&s"(m0), "=&s"(m1), "=&s"(m2), "=&s"(m3), "=&s"(m4), "=&s"(m5), "=&s"(m6), "=&s"(m7)
          : "v"(x[blk * 8 + 0]), "v"(x[blk * 8 + 1]), "v"(x[blk * 8 + 2]), "v"(x[blk * 8 + 3]), "v"(x[blk * 8 + 4]), "v"(x[blk * 8 + 5]),
            "v"(x[blk * 8 + 6]), "v"(x[blk * 8 + 7]), "v"(cand));
    }
    cl += (unsigned)__builtin_amdgcn_update_dpp(0, (int)cl, 0x111, 0xf, 0xf, true);
    cl += (unsigned)__builtin_amdgcn_update_dpp(0, (int)cl, 0x112, 0xf, 0xf, true);
    cl += (unsigned)__builtin_amdgcn_update_dpp(0, (int)cl, 0x114, 0xf, 0xf, true);
    cl += (unsigned)__builtin_amdgcn_update_dpp(0, (int)cl, 0x118, 0xf, 0xf, true);
    const int cnt = __builtin_amdgcn_readlane((int)cl, 15) + __builtin_amdgcn_readlane((int)cl, 31) + __builtin_amdgcn_readlane((int)cl, 47) +
                    __builtin_amdgcn_readlane((int)cl, 63);
    if (cnt >= 256) { tau = cand; cge = cnt; }
    if (cnt == 256) break;
  }
  tau_out = tau;
  cge_out = cge;
}

struct SelPre { bf16x8 af[4]; f32x4 wv[4]; bf16x8 b0[4][4]; };
__device__ __forceinline__ void sel_prefetch(SelPre& p, unsigned char* ws, int r0, const bf16_t* __restrict__ kib, int n, int w, int lane) {
  if (n <= 256) return;
  const int i = lane & 31, kg = lane >> 5;
  const bf16_t* qrow = (const bf16_t*)(ws + W_QI) + (size_t)(r0 + (i >> 2)) * 256 + (i & 3) * 64 + kg * 8;
#pragma unroll
  for (int ks = 0; ks < 4; ++ks) p.af[ks] = *(const bf16x8*)(qrow + ks * 16);
#pragma unroll
  for (int jj = 0; jj < 4; ++jj) p.wv[jj] = *(const f32x4*)((const float*)(ws + W_WI) + (size_t)(r0 + 2 * jj + kg) * 4);
}
__device__ __forceinline__ void sel_prefetch_keys(SelPre& p, const bf16_t* __restrict__ kib, int n, int w, int lane) {
  if (n <= 256) return;
  const int nkb = n >> 5;
#pragma unroll
  for (int u = 0; u < 4; ++u) {
    const int kbu = w + 8 * u < nkb ? w + 8 * u : w;
    const bf16_t* krow = kib + (size_t)kbu * 2048 + lane * 8;
#pragma unroll
    for (int ks = 0; ks < 4; ++ks) p.b0[u][ks] = *(const bf16x8*)(krow + ks * 512);
  }
}
__device__ __forceinline__ void select_group(unsigned char* ws, int r0, const bf16_t* __restrict__ kib, int n, float* sc, SelPre& pre, int nr0, const bf16_t* __restrict__ nkib, int nn) {
  const int tid = otid(), lane = tid & 63, w = tid >> 6;
  unsigned short* SEL = (unsigned short*)(ws + W_SEL);
  if (n <= 256) {
    unsigned short* selrow = SEL + (size_t)(r0 + w) * 256;
    for (int i = lane; i < n; i += 64) selrow[i] = (unsigned short)i;
    if (nn > 0) { sel_prefetch(pre, ws, nr0, nkib, nn, w, lane); sel_prefetch_keys(pre, nkib, nn, w, lane); }
    return;
  }
  {
    const int i = lane & 31, kg = lane >> 5;
    bf16x8 af[4];
    f32x4 wv[4];
#pragma unroll
    for (int ks = 0; ks < 4; ++ks) af[ks] = pre.af[ks];
#pragma unroll
    for (int jj = 0; jj < 4; ++jj) wv[jj] = pre.wv[jj];
    const int nkb = n >> 5;
    for (int kb0 = w; kb0 < nkb; kb0 += 32) {
      bf16x8 bfr[4][4];
      if (kb0 == w) {
#pragma unroll
        for (int u = 0; u < 4; ++u)
#pragma unroll
          for (int ks = 0; ks < 4; ++ks) bfr[u][ks] = pre.b0[u][ks];
      } else {
#pragma unroll
        for (int u = 0; u < 4; ++u) {
          const int kbu = kb0 + 8 * u < nkb ? kb0 + 8 * u : kb0;
          const bf16_t* krow = kib + (size_t)kbu * 2048 + lane * 8;
#pragma unroll
          for (int ks = 0; ks < 4; ++ks) bfr[u][ks] = *(const bf16x8*)(krow + ks * 512);
        }
      }
#pragma unroll
      for (int u = 0; u < 4; ++u) {
        if (kb0 + 8 * u < nkb) {
          const int key = (kb0 + 8 * u) * 32 + i;
          f32x16 acc;
#pragma unroll
          for (int e = 0; e < 16; ++e) acc[e] = 0.f;
#pragma unroll
          for (int ks = 0; ks < 4; ++ks) acc = __builtin_amdgcn_mfma_f32_32x32x16_bf16(af[ks], bfr[u][ks], acc, 0, 0, 0);
#pragma unroll
          for (int jj = 0; jj < 4; ++jj) {
            float sco = wv[jj][0] * fmaxf(acc[4 * jj], 0.f) + wv[jj][1] * fmaxf(acc[4 * jj + 1], 0.f) + wv[jj][2] * fmaxf(acc[4 * jj + 2], 0.f) +
                        wv[jj][3] * fmaxf(acc[4 * jj + 3], 0.f);
            sco += 0.0f;
            sc[(2 * jj + kg) * 4096 + key] = sco;
          }
        }
      }
    }
  }
  __syncthreads();
  if (nn > 0) sel_prefetch_keys(pre, nkib, nn, w, lane);
  {
    const float* rowl = sc + w * 4096 + lane;
    const int nreg = (n + 63) >> 6;
    const int nl = n - lane;
    unsigned x[64];
#pragma unroll
    for (int i = 0; i < 64; ++i) {
      const unsigned ub = __float_as_uint(rowl[i * 64]);
      const unsigned o = ub ^ ((unsigned)((int)ub >> 31) | 0x80000000u);
      x[i] = (i * 64 < nl) ? o : 0u;
    }
    unsigned tau = 0u;
    int cge = 0;
    switch ((nreg + 7) >> 3) {
      case 1: bisect256<1>(x, tau, cge); break;
      case 2: bisect256<2>(x, tau, cge); break;
      case 3: bisect256<3>(x, tau, cge); break;
      case 4: bisect256<4>(x, tau, cge); break;
      case 5: bisect256<5>(x, tau, cge); break;
      case 6: bisect256<6>(x, tau, cge); break;
      case 7: bisect256<7>(x, tau, cge); break;
      default: bisect256<8>(x, tau, cge); break;
    }
    unsigned tau2 = (unsigned)__builtin_amdgcn_readfirstlane((int)tau);
    asm volatile("" : "+s"(tau2));
    unsigned short* selrow = SEL + (size_t)(r0 + w) * 256;
    if (__builtin_amdgcn_readfirstlane(cge) == 256) {
      int myc = 0;
#pragma unroll
      for (int i = 0; i < 64; ++i) myc += (x[i] >= tau2) ? 1 : 0;
      int incl = myc;
#pragma unroll
      for (int d = 1; d < 64; d <<= 1) {
        const int t = __shfl_up(incl, d);
        incl += (lane >= d) ? t : 0;
      }
      int pos = incl - myc;
#pragma unroll
      for (int blk = 0; blk < 8; ++blk) {
        if (blk * 8 < nreg) {
#pragma unroll
          for (int i = blk * 8; i < blk * 8 + 8; ++i) {
            if (x[i] >= tau2) { selrow[pos] = (unsigned short)(i * 64 + lane); ++pos; }
          }
        }
      }
    } else {
      int cgt = 0;
#pragma unroll
      for (int blk = 0; blk < 8; ++blk) {
#pragma unroll
        for (int i = blk * 8; i < blk * 8 + 8; ++i) cgt += __popcll(__ballot(x[i] > tau2));
        __builtin_amdgcn_sched_barrier(0);
      }
      const int rem = 256 - cgt;
      int base = 0, taken = 0;
      unsigned tau3 = tau2;
      asm volatile("" : "+s"(tau3));
#pragma unroll
      for (int blk = 0; blk < 8; ++blk) {
        if (blk * 8 < nreg) {
#pragma unroll
          for (int i = blk * 8; i < blk * 8 + 8; ++i) {
            const bool gt = x[i] > tau3, eq = x[i] == tau3;
            const unsigned long long meq = __ballot(eq);
            const bool take = gt || (eq && (taken + mbcnt64(meq) < rem));
            const unsigned long long msel = __ballot(take);
            const int ps = base + mbcnt64(msel);
            if (take && ps < 256) selrow[ps] = (unsigned short)(i * 64 + lane);
            base += __popcll(msel);
            taken += __popcll(meq);
            __builtin_amdgcn_sched_barrier(0);
          }
        }
      }
    }
  }
  if (nn > 0) sel_prefetch(pre, ws, nr0, nkib, nn, w, lane);
  __syncthreads();
}

__device__ __forceinline__ void sel_params(unsigned char* ws, int l, int tile, int it, int& r0, const bf16_t*& kib, int& n) {
  if (tile < 256) {
    const int b = tile >> 5, cp = tile & 31, c = (it & 8) ? 63 - cp : cp;
    kib = (const bf16_t*)(ws + W_KIP) + (size_t)b * 4096 * 64;
    r0 = b * 4096 + c * 64 + (it & 7) * 8;
    n = 64 * (c + 1);
  } else {
    const int sb = tile - 256;
    kib = (const bf16_t*)(ws + W_KIS) + (size_t)(l * 16 + sb) * 2080 * 64;
    r0 = MP + sb * 32 + it * 8;
    n = 2080;
  }
}
__device__ __forceinline__ void phase_select(KP kp, int l, unsigned char* shm) {
  kp = launder(kp);
  float* sc = (float*)shm;
  unsigned char* ws = kp->ws;
  const int tid = otid(), lane = tid & 63, w = tid >> 6;
  for (int tile0 = blockIdx.x; tile0 < 272; tile0 += gridDim.x) {
    const int tile = tile0 < 256 ? (tile0 & 7) * 32 + (tile0 >> 3) : tile0;
    const int ng = tile >= 256 ? 4 : 16;
    SelPre pre;
    {
      int r0, n; const bf16_t* kib;
      sel_params(ws, l, tile, 0, r0, kib, n);
      sel_prefetch(pre, ws, r0, kib, n, w, lane);
      sel_prefetch_keys(pre, kib, n, w, lane);
    }
    for (int it = 0; it < ng; ++it) {
      int r0, n, nr0 = 0, nn = 0;
      const bf16_t *kib, *nkib = nullptr;
      sel_params(ws, l, tile, it, r0, kib, n);
      if (it + 1 < ng) sel_params(ws, l, tile, it + 1, nr0, nkib, nn);
      select_group(ws, r0, kib, n, sc, pre, nr0, nkib, nn);
    }
  }
}

__device__ __forceinline__ void phase_attn(KP kp, int l, unsigned char* shm) {
  kp = launder(kp);
  const int tid = otid(), lane = tid & 63, w = __builtin_amdgcn_readfirstlane(tid >> 6);
  unsigned char* ws = kp->ws;
  unsigned char* tileb = shm + w * 5120;
  unsigned short* selw = (unsigned short*)(shm + w * 5120 + 4608);
  const unsigned tr_addr = (unsigned)(size_t)tileb + (unsigned)((4 * (lane >> 4) + ((lane & 15) >> 2)) * 144 + (lane & 3) * 8);
  bf16_t* Q = (bf16_t*)(ws + W_Q);
  const unsigned short* SEL = (const unsigned short*)(ws + W_SEL);
  const int nn = lane & 15, kg = lane >> 4;
  const int ks8 = lane >> 3, dc = lane & 7;
  for (int q = blockIdx.x * 8 + w; q < MT; q += gridDim.x * 8) {
    int r = q;
    if (gridDim.x == 256 && q < MP) r = ((q >> 3) & 7) * 4096 + (q >> 11) * 256 + ((q >> 6) & 31) * 8 + (q & 7);
    const bf16_t *kbase, *vbase;
    int n;
    if (r < MP) {
      const int b = r >> 12, t = r & 4095;
      kbase = (const bf16_t*)(ws + W_KP) + (size_t)b * 4096 * 128;
      vbase = (const bf16_t*)(ws + W_VP) + (size_t)b * 4096 * 128;
      n = ((t >> 6) + 1) * 64;
    } else {
      const int sb = (r - MP) >> 5;
      kbase = (const bf16_t*)(ws + W_KS) + (size_t)(l * 16 + sb) * 2080 * 128;
      vbase = (const bf16_t*)(ws + W_VS) + (size_t)(l * 16 + sb) * 2080 * 128;
      n = 2080;
    }
    const int cnt = n < 256 ? n : 256;
    {
      u32x2 sv = *(const u32x2*)(SEL + (size_t)r * 256 + lane * 4);
      const int k0 = lane * 4;
      unsigned a0 = sv[0] & 0xffffu, a1 = sv[0] >> 16, a2 = sv[1] & 0xffffu, a3 = sv[1] >> 16;
      a0 = (k0 < cnt) ? a0 : 0u; a1 = (k0 + 1 < cnt) ? a1 : 0u; a2 = (k0 + 2 < cnt) ? a2 : 0u; a3 = (k0 + 3 < cnt) ? a3 : 0u;
      u32x2 o;
      o[0] = a0 | (a1 << 16); o[1] = a2 | (a3 << 16);
      *(u32x2*)(selw + lane * 4) = o;
    }
    __builtin_amdgcn_wave_barrier();
    bf16x8 kpre[8][2];
#pragma unroll
    for (int kvh = 0; kvh < 2; ++kvh) {
      bf16x8 bq0, bq1;
#pragma unroll
      for (int e = 0; e < 8; ++e) { bq0[e] = 0; bq1[e] = 0; }
      if (nn < 4) {
        const bf16_t* qp = Q + (size_t)r * 512 + (kvh * 4 + nn) * 64 + kg * 8;
        bq0 = *(const bf16x8*)qp;
        bq1 = *(const bf16x8*)(qp + 32);
      }
      f32x4 lg[16];
      for (int repQ = 0; repQ < ((PROBE & 128) ? 2 : 1); ++repQ)
      {
#pragma unroll
        for (int hb = 0; hb < 2; ++hb) {
          bf16x8 ka[8][2];
          if (kvh == 1 && hb == 0) {
#pragma unroll
            for (int k8 = 0; k8 < 8; ++k8) { ka[k8][0] = kpre[k8][0]; ka[k8][1] = kpre[k8][1]; }
          } else {
#pragma unroll
            for (int k8 = 0; k8 < 8; ++k8) {
              const int idx = selw[(hb * 8 + k8) * 16 + nn];
              const bf16_t* kp = kbase + (size_t)idx * 128 + kvh * 64 + kg * 8;
              ka[k8][0] = *(const bf16x8*)kp;
              ka[k8][1] = *(const bf16x8*)(kp + 32);
            }
          }
          __builtin_amdgcn_sched_barrier(0);
#pragma unroll
          for (int k8 = 0; k8 < 8; ++k8) {
            f32x4 a = (f32x4){0.f, 0.f, 0.f, 0.f};
            a = __builtin_amdgcn_mfma_f32_16x16x32_bf16(ka[k8][0], bq0, a, 0, 0, 0);
            a = __builtin_amdgcn_mfma_f32_16x16x32_bf16(ka[k8][1], bq1, a, 0, 0, 0);
            lg[hb * 8 + k8] = a;
          }
          __builtin_amdgcn_sched_barrier(0);
        }
      }
      u32x4 vr[32];
#pragma unroll
      for (int i = 0; i < 16; ++i) {
        const int idx = selw[i * 8 + ks8];
        vr[i] = *(const u32x4*)(vbase + (size_t)idx * 128 + kvh * 64 + dc * 8);
      }
      float mx = -1e30f;
#pragma unroll
      for (int kb = 0; kb < 16; ++kb)
#pragma unroll
        for (int j = 0; j < 4; ++j) {
          const int key = kb * 16 + kg * 4 + j;
          lg[kb][j] = key < cnt ? lg[kb][j] : -1e30f;
          mx = fmaxf(mx, lg[kb][j]);
        }
      mx = fmaxf(mx, __shfl_xor(mx, 16));
      mx = fmaxf(mx, __shfl_xor(mx, 32));
      float sum = 0.f;
#pragma unroll
      for (int kb = 0; kb < 16; ++kb)
#pragma unroll
        for (int j = 0; j < 4; ++j) { lg[kb][j] = __expf(lg[kb][j] - mx); sum += lg[kb][j]; }
      sum += __shfl_xor(sum, 16);
      sum += __shfl_xor(sum, 32);
      const float inv = 1.f / sum;
      bf16x8 pf[8];
#pragma unroll
      for (int s8 = 0; s8 < 8; ++s8) {
        u32x4 pk;
        pk[0] = cvt_pk_bf16(lg[2 * s8][0], lg[2 * s8][1]);
        pk[1] = cvt_pk_bf16(lg[2 * s8][2], lg[2 * s8][3]);
        pk[2] = cvt_pk_bf16(lg[2 * s8 + 1][0], lg[2 * s8 + 1][1]);
        pk[3] = cvt_pk_bf16(lg[2 * s8 + 1][2], lg[2 * s8 + 1][3]);
        pf[s8] = __builtin_bit_cast(bf16x8, pk);
      }
      f32x4 oacc[4];
#pragma unroll
      for (int c = 0; c < 4; ++c) oacc[c] = (f32x4){0.f, 0.f, 0.f, 0.f};
      for (int repV = 0; repV < ((PROBE & 256) ? 2 : 1); ++repV)
      {
        if (repV) {
#pragma unroll
          for (int c = 0; c < 4; ++c) oacc[c] = (f32x4){0.f, 0.f, 0.f, 0.f};
        }
#pragma unroll
        for (int i = 16; i < 32; ++i) {
          const int idx = selw[i * 8 + ks8];
          vr[i] = *(const u32x4*)(vbase + (size_t)idx * 128 + kvh * 64 + dc * 8);
        }
#pragma unroll
        for (int s8 = 0; s8 < 8; ++s8) {
#pragma unroll
          for (int it = 0; it < 4; ++it) *(u32x4*)(tileb + (it * 8 + ks8) * 144 + dc * 16) = vr[s8 * 4 + it];
          u32x2 t0, t1, t2, t3, t4, t5, t6, t7;
          asm volatile(
              "ds_read_b64_tr_b16 %0, %8\n\tds_read_b64_tr_b16 %1, %8 offset:2304\n\t"
              "ds_read_b64_tr_b16 %2, %8 offset:32\n\tds_read_b64_tr_b16 %3, %8 offset:2336\n\t"
              "ds_read_b64_tr_b16 %4, %8 offset:64\n\tds_read_b64_tr_b16 %5, %8 offset:2368\n\t"
              "ds_read_b64_tr_b16 %6, %8 offset:96\n\tds_read_b64_tr_b16 %7, %8 offset:2400\n\t"
              "s_waitcnt lgkmcnt(0)"
              : "=&v"(t0), "=&v"(t1), "=&v"(t2), "=&v"(t3), "=&v"(t4), "=&v"(t5), "=&v"(t6), "=&v"(t7)
              : "v"(tr_addr)
              : "memory");
          const bf16x8 a0 = __builtin_bit_cast(bf16x8, (u32x4){t0[0], t0[1], t1[0], t1[1]});
          const bf16x8 a1 = __builtin_bit_cast(bf16x8, (u32x4){t2[0], t2[1], t3[0], t3[1]});
          const bf16x8 a2 = __builtin_bit_cast(bf16x8, (u32x4){t4[0], t4[1], t5[0], t5[1]});
          const bf16x8 a3 = __builtin_bit_cast(bf16x8, (u32x4){t6[0], t6[1], t7[0], t7[1]});
          oacc[0] = __builtin_amdgcn_mfma_f32_16x16x32_bf16(a0, pf[s8], oacc[0], 0, 0, 0);
          oacc[1] = __builtin_amdgcn_mfma_f32_16x16x32_bf16(a1, pf[s8], oacc[1], 0, 0, 0);
          oacc[2] = __builtin_amdgcn_mfma_f32_16x16x32_bf16(a2, pf[s8], oacc[2], 0, 0, 0);
          oacc[3] = __builtin_amdgcn_mfma_f32_16x16x32_bf16(a3, pf[s8], oacc[3], 0, 0, 0);
          if (kvh == 0 && s8 == 3) {
#pragma unroll
            for (int k8 = 0; k8 < 8; ++k8) {
              const int idx = selw[k8 * 16 + nn];
              const bf16_t* kp = kbase + (size_t)idx * 128 + 64 + kg * 8;
              kpre[k8][0] = *(const bf16x8*)kp;
              kpre[k8][1] = *(const bf16x8*)(kp + 32);
            }
          }
        }
        __builtin_amdgcn_sched_barrier(0);
      }
      if (nn < 4) {
#pragma unroll
        for (int c = 0; c < 4; ++c) {
          u32x2 ow;
          ow[0] = cvt_pk_bf16(oacc[c][0] * inv, oacc[c][1] * inv);
          ow[1] = cvt_pk_bf16(oacc[c][2] * inv, oacc[c][3] * inv);
          *(u32x2*)((bf16_t*)(ws + W_OA) + (size_t)r * 512 + (kvh * 4 + nn) * 64 + 16 * c + 4 * kg) = ow;
        }
      }
      __builtin_amdgcn_wave_barrier();
    }
  }
}

__device__ __forceinline__ void phase_ln(float* R, const float* __restrict__ g, const float* __restrict__ b, bf16_t* xbf, float samp_scale, const float* __restrict__ part, int nsplit, bool f32_all) {
  const int tid = otid(), lane = tid & 63, gw = blockIdx.x * 8 + (tid >> 6), nw = gridDim.x * 8;
  f32x4 gv[4], bv[4];
#pragma unroll
  for (int i = 0; i < 4; ++i) { gv[i] = *(const f32x4*)(g + i * 256 + lane * 4); bv[i] = *(const f32x4*)(b + i * 256 + lane * 4); }
  for (int r = gw; r < MT; r += nw) {
    float* row = R + (size_t)r * 1024;
    f32x4 v[4];
#pragma unroll
    for (int i = 0; i < 4; ++i) v[i] = *(const f32x4*)(row + i * 256 + lane * 4);
    if (r >= MP) {
      for (int sp = 0; sp < nsplit; ++sp) {
        const float* prow = part + ((size_t)sp * MS + (r - MP)) * 1024;
#pragma unroll
        for (int i = 0; i < 4; ++i) v[i] = v[i] + *(const f32x4*)(prow + i * 256 + lane * 4);
      }
    }
    float s = 0.f;
#pragma unroll
    for (int i = 0; i < 4; ++i) s += v[i][0] + v[i][1] + v[i][2] + v[i][3];
#pragma unroll
    for (int o = 32; o >= 1; o >>= 1) s += __shfl_xor(s, o);
    const float mean = s * (1.f / 1024.f);
    float ss = 0.f;
#pragma unroll
    for (int i = 0; i < 4; ++i) { v[i] = v[i] - mean; ss += v[i][0] * v[i][0] + v[i][1] * v[i][1] + v[i][2] * v[i][2] + v[i][3] * v[i][3]; }
#pragma unroll
    for (int o = 32; o >= 1; o >>= 1) ss += __shfl_xor(ss, o);
    const float rstd = rsqrtf(ss * (1.f / 1024.f) + LN_EPS);
#pragma unroll
    for (int i = 0; i < 4; ++i) {
      const f32x4 y = v[i] * rstd * gv[i] + bv[i];
      if (r >= MP) *(f32x4*)(row + i * 256 + lane * 4) = y * samp_scale;
      else if (f32_all) *(f32x4*)(row + i * 256 + lane * 4) = y;
      if (xbf) {
        u32x2 wv;
        wv[0] = cvt_pk_bf16(y[0], y[1]); wv[1] = cvt_pk_bf16(y[2], y[3]);
        *(u32x2*)(xbf + (size_t)r * 1024 + i * 256 + lane * 4) = wv;
      }
    }
  }
}

__device__ __forceinline__ void tile32(const bf16_t* __restrict__ A, int lda, const bf16_t* __restrict__ Bt, int ldb, int K, int row0, int col0, int lane, f32x4 (&c)[2][2]) {
  const int i = lane & 15, kg = lane >> 4;
  const bf16_t* a0 = A + (size_t)(row0 + i) * lda + kg * 8;
  const bf16_t* a1 = a0 + (size_t)16 * lda;
  const bf16_t* b0 = Bt + (size_t)(col0 + i) * ldb + kg * 8;
  const bf16_t* b1 = b0 + (size_t)16 * ldb;
#pragma unroll 4
  for (int k = 0; k < K; k += 32) {
    const bf16x8 af0 = *(const bf16x8*)(a0 + k), af1 = *(const bf16x8*)(a1 + k), bf0 = *(const bf16x8*)(b0 + k), bf1 = *(const bf16x8*)(b1 + k);
    c[0][0] = __builtin_amdgcn_mfma_f32_16x16x32_bf16(af0, bf0, c[0][0], 0, 0, 0);
    c[0][1] = __builtin_amdgcn_mfma_f32_16x16x32_bf16(af0, bf1, c[0][1], 0, 0, 0);
    c[1][0] = __builtin_amdgcn_mfma_f32_16x16x32_bf16(af1, bf0, c[1][0], 0, 0, 0);
    c[1][1] = __builtin_amdgcn_mfma_f32_16x16x32_bf16(af1, bf1, c[1][1], 0, 0, 0);
  }
}
__device__ __forceinline__ void sample_proj(unsigned char* ws, int l) {
  const int tid = otid(), lane = tid & 63, gw = blockIdx.x * 8 + (tid >> 6), nw = gridDim.x * 8;
  const bf16_t* GA = (const bf16_t*)(ws + W_GA);
  const bf16_t* GB = (const bf16_t*)(ws + W_GB);
  bf16_t* MRG = (bf16_t*)(ws + W_MRG);
  for (int t = gw; t < 16 * 32; t += nw) {
    const int row0 = MP + (t >> 5) * 32, col0 = (t & 31) * 32;
    f32x4 ca[2][2], cb[2][2];
#pragma unroll
    for (int x = 0; x < 2; ++x)
#pragma unroll
      for (int y = 0; y < 2; ++y) { ca[x][y] = (f32x4){0.f, 0.f, 0.f, 0.f}; cb[x][y] = (f32x4){0.f, 0.f, 0.f, 0.f}; }
    tile32((const bf16_t*)(ws + W_OA), 512, (const bf16_t*)(ws + W_WPA) + (size_t)l * 1024 * 512, 512, 512, row0, col0, lane, ca);
    tile32((const bf16_t*)(ws + W_U), 512, (const bf16_t*)(ws + W_WPB) + (size_t)l * 1024 * 512, 512, 512, row0, col0, lane, cb);
#pragma unroll
    for (int rb = 0; rb < 2; ++rb)
#pragma unroll
      for (int cc = 0; cc < 2; ++cc)
#pragma unroll
        for (int j = 0; j < 4; ++j) {
          const size_t o = (size_t)(row0 + 16 * rb + (lane >> 4) * 4 + j) * 1024 + col0 + 16 * cc + (lane & 15);
          const float m = ((float)((const unsigned char*)GA)[o] * ca[rb][cc][j] + (float)((const unsigned char*)GB)[o] * cb[rb][cc][j]) * (1.f / 255.f);
          MRG[o] = (bf16_t)(cvt_pk_bf16(m, 0.f) & 0xffffu);
        }
  }
}
__device__ __forceinline__ void sample_ff1(unsigned char* ws, int l) {
  const int tid = otid(), lane = tid & 63, gw = blockIdx.x * 8 + (tid >> 6), nw = gridDim.x * 8;
  bf16_t* H = (bf16_t*)(ws + W_H);
  for (int t = gw; t < 16 * 128; t += nw) {
    const int row0 = MP + (t >> 7) * 32, col0 = (t & 127) * 32;
    f32x4 c[2][2];
#pragma unroll
    for (int x = 0; x < 2; ++x)
#pragma unroll
      for (int y = 0; y < 2; ++y) c[x][y] = (f32x4){0.f, 0.f, 0.f, 0.f};
    tile32((const bf16_t*)(ws + W_XBF), 1024, (const bf16_t*)(ws + W_FF1) + (size_t)l * 4096 * 1024, 1024, 1024, row0, col0, lane, c);
#pragma unroll
    for (int rb = 0; rb < 2; ++rb)
#pragma unroll
      for (int cc = 0; cc < 2; ++cc)
#pragma unroll
        for (int j = 0; j < 4; ++j) {
          const float a = fmaxf(c[rb][cc][j], 0.f);
          H[(size_t)(row0 + 16 * rb + (lane >> 4) * 4 + j) * LDH + col0 + 16 * cc + (lane & 15)] = (bf16_t)(cvt_pk_bf16(a * a, 0.f) & 0xffffu);
        }
  }
}

#define XB_TMO      128
#define XB_XCNT(j)  (256  + 64 * (j))
#define XB_XSUB(j)  (1280 + 64 * (j))
#define XB_XGEN(j)  (2304 + 64 * (j))
#define XB_TOP      3328
#define XB_TOPGEN   3392
#define XCD_BAR_WORDS 3456
#define XB_SPIN_CAP (1u << 18)
__device__ __forceinline__ unsigned xb_ld(unsigned* p) { return __hip_atomic_load(p, __ATOMIC_RELAXED, __HIP_MEMORY_SCOPE_AGENT); }
__device__ __forceinline__ unsigned xb_add(unsigned* p, unsigned v) { return __hip_atomic_fetch_add(p, v, __ATOMIC_RELAXED, __HIP_MEMORY_SCOPE_AGENT); }
__device__ __forceinline__ unsigned xb_xcc_id() { return (unsigned)__builtin_amdgcn_s_getreg((3 << 11) | 20) & 0xFu; }
#define XB_SPIN(cond, bar) do { unsigned _sp = 0; while (cond) { __builtin_amdgcn_s_sleep(1); \
    if ((++_sp & 255u) == 0u) { if (xb_ld(&(bar)[XB_TMO])) break; if (_sp > XB_SPIN_CAP) { atomicAdd(&(bar)[XB_TMO], 1u); break; } } } } while (0)
__device__ __forceinline__ void xcd_barrier_complete(unsigned* bar, unsigned x, unsigned& nloc, unsigned& nx) {
  const unsigned G = gridDim.x * gridDim.y * gridDim.z;
  unsigned sum, cnt, mine, sp = 0u;
  for (;;) {
    sum = 0u; cnt = 0u; mine = 0u;
#pragma unroll
    for (unsigned j = 0; j < 16; ++j) { const unsigned c = xb_ld(&bar[XB_XCNT(j)]); sum += c; cnt += (c > 0u) ? 1u : 0u; mine = (j == x) ? c : mine; }
    if (sum == G) break;
    __builtin_amdgcn_s_sleep(1);
    if ((++sp & 255u) == 0u) { if (xb_ld(&bar[XB_TMO])) break; if (sp > XB_SPIN_CAP) { atomicAdd(&bar[XB_TMO], 1u); break; } }
  }
  nloc = mine > 0u ? mine : 1u; nx = cnt > 0u ? cnt : 1u;
}
__device__ __forceinline__ void xcd_barrier(KP kp, volatile LAS unsigned* st) {
  asm volatile("s_waitcnt vmcnt(0)" ::: "memory");
  __syncthreads();
  if (threadIdx.x == 0) {
    unsigned* bar = (unsigned*)(launder(kp)->ws + W_BAR);
    const unsigned x = xb_xcc_id();
    __builtin_amdgcn_s_waitcnt(0);
    unsigned nloc = st[0], nx = st[1];
    if (nloc == 0u) { xcd_barrier_complete(bar, x, nloc, nx); st[0] = nloc; st[1] = nx; }
    const unsigned old = xb_add(&bar[XB_XSUB(x)], 1u);
    const unsigned gen = old / nloc;
    if (old + 1u == (gen + 1u) * nloc) {
      __builtin_amdgcn_fence(__ATOMIC_RELEASE, "agent");
      asm volatile("s_waitcnt vmcnt(0)" ::: "memory");
      const unsigned og = xb_add(&bar[XB_TOP], 1u);
      const unsigned tg = og / nx;
      if (og + 1u == (tg + 1u) * nx) xb_add(&bar[XB_TOPGEN], 1u);
      else XB_SPIN(xb_ld(&bar[XB_TOPGEN]) == tg, bar);
      __builtin_amdgcn_fence(__ATOMIC_ACQUIRE, "agent");
      xb_add(&bar[XB_XGEN(x)], 1u);
      asm volatile("s_waitcnt vmcnt(0)" ::: "memory");
    } else {
      XB_SPIN(xb_ld(&bar[XB_XGEN(x)]) == gen, bar);
      __builtin_amdgcn_fence(__ATOMIC_ACQUIRE, "agent");
      asm volatile("s_waitcnt vmcnt(0)" ::: "memory");
    }
  }
  __syncthreads();
}

#ifndef PH_MASK
#define PH_MASK 0xFFFF
#endif
__global__ void __launch_bounds__(512, 2) mega(Params p_unused) {
  extern __shared__ __attribute__((aligned(16))) unsigned char shm[];
  cg::grid_group grid = cg::this_grid();
  LAS unsigned char* lds = (LAS unsigned char*)shm;
  const KP kp0 = (KP)__builtin_amdgcn_kernarg_segment_ptr();
  volatile LAS unsigned* st = (volatile LAS unsigned*)(lds + 139264);
  if (threadIdx.x < 2) st[threadIdx.x] = 0u;
  __syncthreads();
  if (threadIdx.x == 0) (void)xb_add(&((unsigned*)(kp0->ws + W_BAR))[XB_XCNT(xb_xcc_id())], 1u);

  for (int rep = 0; rep < ((PROBE & 4) ? 2 : 1); ++rep)
  if (PH_MASK & 1) phase_prep(kp0, shm);
  if (kp0->ws == nullptr) grid.sync();
  xcd_barrier(kp0, st);
#pragma unroll 1
  for (int l = 0; l < 2; ++l) {
    for (int rep = 0; rep < ((PROBE & 1) ? 2 : 1); ++rep)
    if (PH_MASK & 2) {
      const KP kp = launder(kp0);
      unsigned char* ws = kp->ws;
      pg8::Gemm g{(bf16_t*)(ws + W_XBF), (const bf16_t*)(ws + W_WIN) + (size_t)l * NPK * 1024, MT, NPK, 1024, 1024, 1024, nullptr, nullptr};
      pg8::StaticOrder S;
      S.init(g.N, g.K, 1, gridDim.x, blockIdx.x);
      EpiIn E{l, kp->out, ws};
      pg8::gemm_phase(lds, g, S, E);
    }
    xcd_barrier(kp0, st);
    if (PH_MASK & 4) phase_fix(kp0, l, shm);
    xcd_barrier(kp0, st);
    for (int rep = 0; rep < ((PROBE & 2) ? 2 : 1); ++rep)
    if (PH_MASK & 8) phase_select(kp0, l, shm);
    xcd_barrier(kp0, st);
    for (int rep = 0; rep < ((PROBE & 32) ? 2 : 1); ++rep)
    if (PH_MASK & 16) phase_attn(kp0, l, shm);
    xcd_barrier(kp0, st);
    for (int rep = 0; rep < ((PROBE & 1024) ? 2 : 1); ++rep)
    if (PH_MASK & 32) {
      const KP kp = launder(kp0);
      unsigned char* ws = kp->ws;
      sample_proj(ws, l);
      pg8::StaticOrder S;
      S.init(1024, 512, 0, gridDim.x, blockIdx.x);
      {
        pg8::Gemm g{(const bf16_t*)(ws + W_OA), (const bf16_t*)(ws + W_WPA) + (size_t)l * 1024 * 512, MT, 1024, 512, 512, 512,
                    (const bf16_t*)(ws + W_U), (const bf16_t*)(ws + W_WPB) + (size_t)l * 1024 * 512};
        S.dual = 1;
        EpiGate E{(const unsigned char*)(ws + W_GA), (const unsigned char*)(ws + W_GB), (bf16_t*)(ws + W_MRG)};
        pg8::gemm_phase(lds, g, S, E);
      }
    }
    xcd_barrier(kp0, st);
    for (int rep = 0; rep < ((PROBE & 2048) ? 2 : 1); ++rep)
    if (PH_MASK & 64) {
      const KP kp = launder(kp0);
      unsigned char* ws = kp->ws;
      float* R = kp->out + O_Y;
      pg8::Gemm g{(bf16_t*)(ws + W_MRG), (const bf16_t*)(ws + W_WOUT) + (size_t)l * 1024 * 1024, MT, 1024, 1024, 1024, 1024, nullptr, nullptr};
      pg8::StaticOrder S;
      S.init(g.N, g.K, 4, gridDim.x, blockIdx.x);
      EpiRes E{l == 0 ? kp->x_prompt : nullptr, (const bf16_t*)(ws + W_XBF), R, (float*)(ws + W_PART)};
      pg8::gemm_phase(lds, g, S, E);
    }
    xcd_barrier(kp0, st);
    if (PH_MASK & 128) {
      const KP kp = launder(kp0);
      phase_ln(kp->out + O_Y, kp->ln1_g + l * 1024, kp->ln1_b + l * 1024, (bf16_t*)(kp->ws + W_XBF), ALPHA, (const float*)(kp->ws + W_PART), 4, false);
    }
    xcd_barrier(kp0, st);
    for (int rep = 0; rep < ((PROBE & 512) ? 2 : 1); ++rep)
    if (PH_MASK & 256) {
      const KP kp = launder(kp0);
      unsigned char* ws = kp->ws;
      sample_ff1(ws, l);
      pg8::Gemm g{(bf16_t*)(ws + W_XBF), (const bf16_t*)(ws + W_FF1) + (size_t)l * 4096 * 1024, MT, DFF, 1024, 1024, 1024, nullptr, nullptr};
      pg8::StaticOrder S;
      S.init(g.N, g.K, 0, gridDim.x, blockIdx.x);
      EpiFF1 E{(bf16_t*)(ws + W_H)};
      pg8::gemm_phase(lds, g, S, E);
    }
    xcd_barrier(kp0, st);
    for (int rep = 0; rep < ((PROBE & 4096) ? 2 : 1); ++rep)
    if (PH_MASK & 512) {
      const KP kp = launder(kp0);
      unsigned char* ws = kp->ws;
      float* R = kp->out + O_Y;
      pg8::Gemm g{(const bf16_t*)(ws + W_H), (const bf16_t*)(ws + W_FF2) + (size_t)l * 1024 * LDH, MT, 1024, 4096, LDH, LDH, nullptr, nullptr};
      pg8::StaticOrder S;
      S.init(g.N, g.K, 8, gridDim.x, blockIdx.x);
      EpiRes E{nullptr, (const bf16_t*)(ws + W_XBF), R, (float*)(ws + W_PART)};
      pg8::gemm_phase(lds, g, S, E);
    }
    xcd_barrier(kp0, st);
    if (PH_MASK & 1024) {
      const KP kp = launder(kp0);
      phase_ln(kp->out + O_Y, kp->ln2_g + l * 1024, kp->ln2_b + l * 1024, l == 0 ? (bf16_t*)(kp->ws + W_XBF) : nullptr, l == 0 ? ALPHA : 1.0f, (const float*)(kp->ws + W_PART), 8, l == 1);
    }
    xcd_barrier(kp0, st);
  }
  if (PROBE & 64) { for (int q = 0; q < 40; ++q) xcd_barrier(kp0, st); }
}

extern "C" void kernel_launch(void* const* d_in, const int* in_sizes, int n_in, void* d_out, int out_size, void* d_ws, size_t ws_size,
                              hipStream_t stream) {
  static int grid_blocks = 0;
  if (!grid_blocks) {
    int dev = 0, cus = 0, per_cu = 0;
    if (n_in != 21 || (size_t)out_size != O_END || ws_size < W_END) {
      fprintf(stderr, "kernel_launch: unexpected sizes n_in %d out %d ws %zu (need %zu)\n", n_in, out_size, ws_size, (size_t)W_END);
      grid_blocks = -1;
      return;
    }
    if (hipGetDevice(&dev) != hipSuccess || hipDeviceGetAttribute(&cus, hipDeviceAttributeMultiprocessorCount, dev) != hipSuccess) { grid_blocks = -1; return; }
    if (hipFuncSetAttribute((const void*)mega, hipFuncAttributeMaxDynamicSharedMemorySize, LDS_BYTES) != hipSuccess) { grid_blocks = -1; return; }
    if (hipOccupancyMaxActiveBlocksPerMultiprocessor(&per_cu, (const void*)mega, 512, LDS_BYTES) != hipSuccess || per_cu < 1) {
      fprintf(stderr, "kernel_launch: occupancy query says %d blocks/CU\n", per_cu);
      grid_blocks = -1;
      return;
    }
    grid_blocks = cus;
  }
  if (grid_blocks < 0) return;
  Params p{};
  const float** pp = (const float**)&p;
  for (int i = 0; i < 21; ++i) pp[i] = (const float*)d_in[i];
  p.out = (float*)d_out;
  p.ws = (unsigned char*)d_ws;
  if (hipMemsetAsync((unsigned char*)d_ws + W_BAR, 0, 16384, stream) != hipSuccess) { fprintf(stderr, "kernel_launch: memset of barrier words failed\n"); return; }
  void* args[] = {&p};
  hipError_t e = hipLaunchCooperativeKernel((void*)mega, dim3(grid_blocks), dim3(512), args, LDS_BYTES, stream);
  if (e != hipSuccess) fprintf(stderr, "cooperative launch failed: %s (grid %d)\n", hipGetErrorString(e), grid_blocks);
}
```
